# Optimizing an MI355X kernel written in HIP

```python
import math
import jax
import jax.numpy as jnp
from jax import lax
import numpy as np

D_MODEL = 1024
BATCH = 4
SEQ = 4096
DEPTH = 1
DEC_BATCH = 128
DEC_SEQ = 4
PAST_LEN = 2048
PAGE_SIZE = 128

ATT_WIDTH = D_MODEL // 2
LRU_WIDTH = D_MODEL - ATT_WIDTH
ATT_HEADS = 4
V_HEAD_DIM = ATT_WIDTH // ATT_HEADS
QK_SUB_DIM = V_HEAD_DIM // 2
ROPE_DIM = QK_SUB_DIM // 4
ROPE_THETA = 500000.0
LRU_BLOCKS = 8
LRU_BLOCK_DIM = LRU_WIDTH // LRU_BLOCKS
LRU_C = 8.0
LRU_CONV = 4
D_FF = ((8 * D_MODEL // 3 + 127) // 128) * 128
FFN_CONV = 3
Q_BLOCK = 128
IN_WIDTH = 3 * ATT_WIDTH + 2 * LRU_WIDTH
EPS = 1e-6
F32 = jnp.float32

kernel_name = 'hymba_diffattn_rglru_convffn_step'


def lambda_init(layer):
    return 0.8 - 0.6 * math.exp(-0.3 * layer)


def rmsnorm(x, g):
    xf = x.astype(F32)
    y = xf * lax.rsqrt(jnp.mean(xf * xf, axis=-1, keepdims=True) + EPS)
    return (y * g.astype(F32)).astype(x.dtype)


def partial_rope(t, pos):
    half = ROPE_DIM // 2
    freqs = ROPE_THETA ** (-jnp.arange(half, dtype=F32) * 2.0 / ROPE_DIM)
    ang = pos.astype(F32)[:, None] * freqs[None, :]
    cos = jnp.cos(ang)[None, :, None, None, :]
    sin = jnp.sin(ang)[None, :, None, None, :]
    tf = t.astype(F32)
    r1 = tf[..., :half]
    r2 = tf[..., half:ROPE_DIM]
    out = jnp.concatenate([r1 * cos - r2 * sin, r1 * sin + r2 * cos, tf[..., ROPE_DIM:]], axis=-1)
    return out.astype(t.dtype)


def causal_dwconv(xpad, w, b):
    k_w = w.shape[0]
    t_len = xpad.shape[1] - k_w + 1
    out = xpad[:, 0:t_len] * w[0]
    for k in range(1, k_w):
        out = out + xpad[:, k:k + t_len] * w[k]
    return out + b


def diff_attn_block(q, k, v, mask, lam):
    s = jnp.einsum('bqhcd,bkhcd->bhcqk', q.astype(F32), k.astype(F32)) * (QK_SUB_DIM ** -0.5)
    s = jnp.where(mask, s, jnp.finfo(F32).min)
    p = jax.nn.softmax(s, axis=-1)
    p_diff = p[:, :, 0] - lam * p[:, :, 1]
    return jnp.einsum('bhqk,bkhd->bqhd', p_diff, v.astype(F32))


def diff_attn_prompt(q, k, v, lam):
    bsz, s_len = q.shape[0], q.shape[1]
    n_blk = s_len // Q_BLOCK
    kf = k.astype(F32)
    vf = v.astype(F32)
    qb = q.astype(F32).reshape(bsz, n_blk, Q_BLOCK, ATT_HEADS, 2, QK_SUB_DIM).swapaxes(0, 1)
    k_pos = jnp.arange(s_len)

    def one_block(args):
        q_i, i = args
        q_pos = i * Q_BLOCK + jnp.arange(Q_BLOCK)
        return diff_attn_block(q_i, kf, vf, k_pos[None, :] <= q_pos[:, None], lam)

    ob = lax.map(one_block, (qb, jnp.arange(n_blk)))
    return ob.swapaxes(0, 1).reshape(bsz, s_len, ATT_HEADS, V_HEAD_DIM)


def diff_attn_sample(q, k_new, v_new, k_past, v_past, lam):
    past = k_past.shape[1]
    t_len = q.shape[1]
    k_all = jnp.concatenate([k_past, k_new.astype(k_past.dtype)], axis=1)
    v_all = jnp.concatenate([v_past, v_new.astype(v_past.dtype)], axis=1)
    q_pos = past + jnp.arange(t_len)
    k_pos = jnp.arange(past + t_len)
    return diff_attn_block(q, k_all, v_all, k_pos[None, :] <= q_pos[:, None], lam)


def lru_combine(left, right):
    a1, b1 = left
    a2, b2 = right
    return a1 * a2, a2 * b1 + b2


def rg_lru(xc, h0, w_r, b_r, w_i, b_i, lru_lambda):
    bsz, t_len = xc.shape[0], xc.shape[1]
    xf = xc.astype(F32)
    xb = xf.reshape(bsz, t_len, LRU_BLOCKS, LRU_BLOCK_DIM)
    r = jax.nn.sigmoid(jnp.einsum('btni,nij->btnj', xb, w_r.astype(F32)) + b_r.astype(F32)).reshape(bsz, t_len, LRU_WIDTH)
    ig = jax.nn.sigmoid(jnp.einsum('btni,nij->btnj', xb, w_i.astype(F32)) + b_i.astype(F32)).reshape(bsz, t_len, LRU_WIDTH)
    log_a = -LRU_C * r * jax.nn.softplus(-lru_lambda.astype(F32))
    a = jnp.exp(log_a)
    gated_x = jnp.sqrt(-jnp.expm1(2.0 * log_a)) * (ig * xf)
    gated_x = gated_x.at[:, 0].add(a[:, 0] * h0.astype(F32))
    _, hs = lax.associative_scan(lru_combine, (a, gated_x), axis=1)
    return hs, hs[:, -1]


def layer_forward(x, c, pos, attn_past, lru_buf, lru_h0, ffn_buf, p, lam_init):
    dt = x.dtype
    bsz, t_len = x.shape[0], x.shape[1]
    mod = jax.nn.silu(c.astype(F32)) @ p['w_ada'].astype(F32) + p['b_ada'].astype(F32)
    mod = mod.astype(dt)[:, None, :]
    sh1, sc1, gt1, sh2, sc2, gt2 = jnp.split(mod, 6, axis=-1)

    u = rmsnorm(x, p['g_norm1']) * (1 + sc1) + sh1
    proj = u @ p['w_in']
    q, k, v, lx, lg = jnp.split(proj, [ATT_WIDTH, 2 * ATT_WIDTH, 3 * ATT_WIDTH, 3 * ATT_WIDTH + LRU_WIDTH], axis=-1)
    q = partial_rope(rmsnorm(q.reshape(bsz, t_len, ATT_HEADS, 2, QK_SUB_DIM), p['g_q']), pos)
    k = partial_rope(rmsnorm(k.reshape(bsz, t_len, ATT_HEADS, 2, QK_SUB_DIM), p['g_k']), pos)
    v = v.reshape(bsz, t_len, ATT_HEADS, V_HEAD_DIM)
    lam = (jnp.exp(jnp.sum(p['lam_q1'].astype(F32) * p['lam_k1'].astype(F32)))
           - jnp.exp(jnp.sum(p['lam_q2'].astype(F32) * p['lam_k2'].astype(F32))) + lam_init)
    if attn_past is None:
        o = diff_attn_prompt(q, k, v, lam)
    else:
        o = diff_attn_sample(q, k, v, attn_past[0], attn_past[1], lam)
    o = rmsnorm(o, p['g_subln']) * (1.0 - lam_init)
    attn_out = o.reshape(bsz, t_len, ATT_WIDTH).astype(dt)

    lx_pad = jnp.concatenate([lru_buf.astype(dt), lx], axis=1)
    xc = causal_dwconv(lx_pad, p['conv_lru_w'], p['conv_lru_b'])
    new_lru_buf = lx_pad[:, -(LRU_CONV - 1):]
    hs, h_last = rg_lru(xc, lru_h0, p['w_rgate'], p['b_rgate'], p['w_igate'], p['b_igate'], p['lru_lambda'])
    lru_out = (hs * jax.nn.gelu(lg.astype(F32), approximate=True)).astype(dt)

    m = jnp.concatenate([attn_out, lru_out], axis=-1) @ p['w_out']
    x = x + gt1 * m

    u2 = rmsnorm(x, p['g_norm2']) * (1 + sc2) + sh2
    up = u2 @ p['w_up']
    up_pad = jnp.concatenate([ffn_buf.astype(dt), up], axis=1)
    hc = causal_dwconv(up_pad, p['conv_ffn_w'], p['conv_ffn_b'])
    new_ffn_buf = up_pad[:, -(FFN_CONV - 1):]
    g, val = jnp.split(hc, 2, axis=-1)
    x = x + gt2 * ((jax.nn.silu(g) * val) @ p['w_down'])
    return x, (k, v, new_lru_buf, h_last.astype(dt), new_ffn_buf)


def setup_inputs(seed: int = 0) -> dict:
    key = jax.random.key(seed)
    ks = jax.random.split(key, 40)
    n_pages = PAST_LEN // PAGE_SIZE
    n_used = DEC_BATCH * n_pages
    n_pool = n_used + max(1, n_used // 4)
    L = DEPTH

    def nrm(k, shape, s):
        return s * jax.random.normal(k, shape, F32)

    page_table = jax.random.permutation(ks[4], n_pool)[:n_used].reshape(DEC_BATCH, n_pages).astype(jnp.int32)
    u = jax.random.uniform(ks[30], (L, LRU_WIDTH), F32, 0.9, 0.999)
    a = u ** (1.0 / LRU_C)
    lru_lambda = jnp.log(a) - jnp.log1p(-a)
    return {
        'x_prompt': nrm(ks[0], (BATCH, SEQ, D_MODEL), 1.0),
        'x_sample': nrm(ks[1], (DEC_BATCH, DEC_SEQ, D_MODEL), 1.0),
        'cache_k': nrm(ks[2], (L, n_pool, PAGE_SIZE, ATT_HEADS, 2, QK_SUB_DIM), 1.0),
        'cache_v': nrm(ks[3], (L, n_pool, PAGE_SIZE, ATT_HEADS, V_HEAD_DIM), 1.0),
        'page_table': page_table,
        'state_lru_conv': nrm(ks[5], (L, DEC_BATCH, LRU_CONV - 1, LRU_WIDTH), 1.0),
        'state_lru_h': nrm(ks[6], (L, DEC_BATCH, LRU_WIDTH), 0.5),
        'state_ffn_conv': nrm(ks[7], (L, DEC_BATCH, FFN_CONV - 1, 2 * D_FF), 1.0),
        'c_prompt': nrm(ks[8], (BATCH, D_MODEL), 1.0),
        'c_sample': nrm(ks[9], (DEC_BATCH, D_MODEL), 1.0),
        'g_norm1': 1.0 + nrm(ks[10], (L, D_MODEL), 0.02),
        'g_norm2': 1.0 + nrm(ks[11], (L, D_MODEL), 0.02),
        'w_ada': nrm(ks[12], (L, D_MODEL, 6 * D_MODEL), 0.5 * D_MODEL ** -0.5),
        'b_ada': nrm(ks[13], (L, 6 * D_MODEL), 0.02),
        'w_in': nrm(ks[14], (L, D_MODEL, IN_WIDTH), D_MODEL ** -0.5),
        'g_q': 1.0 + nrm(ks[15], (L, QK_SUB_DIM), 0.02),
        'g_k': 1.0 + nrm(ks[16], (L, QK_SUB_DIM), 0.02),
        'lam_q1': nrm(ks[17], (L, QK_SUB_DIM), 0.1),
        'lam_k1': nrm(ks[18], (L, QK_SUB_DIM), 0.1),
        'lam_q2': nrm(ks[19], (L, QK_SUB_DIM), 0.1),
        'lam_k2': nrm(ks[20], (L, QK_SUB_DIM), 0.1),
        'g_subln': 1.0 + nrm(ks[21], (L, V_HEAD_DIM), 0.02),
        'w_out': nrm(ks[22], (L, ATT_WIDTH + LRU_WIDTH, D_MODEL), (ATT_WIDTH + LRU_WIDTH) ** -0.5),
        'conv_lru_w': nrm(ks[23], (L, LRU_CONV, LRU_WIDTH), LRU_CONV ** -0.5),
        'conv_lru_b': nrm(ks[24], (L, LRU_WIDTH), 0.02),
        'w_rgate': nrm(ks[25], (L, LRU_BLOCKS, LRU_BLOCK_DIM, LRU_BLOCK_DIM), LRU_BLOCK_DIM ** -0.5),
        'b_rgate': nrm(ks[26], (L, LRU_BLOCKS, LRU_BLOCK_DIM), 0.02),
        'w_igate': nrm(ks[27], (L, LRU_BLOCKS, LRU_BLOCK_DIM, LRU_BLOCK_DIM), LRU_BLOCK_DIM ** -0.5),
        'b_igate': nrm(ks[28], (L, LRU_BLOCKS, LRU_BLOCK_DIM), 0.02),
        'lru_lambda': lru_lambda,
        'w_up': nrm(ks[31], (L, D_MODEL, 2 * D_FF), D_MODEL ** -0.5),
        'conv_ffn_w': nrm(ks[32], (L, FFN_CONV, 2 * D_FF), FFN_CONV ** -0.5),
        'conv_ffn_b': nrm(ks[33], (L, 2 * D_FF), 0.02),
        'w_down': nrm(ks[34], (L, D_FF, D_MODEL), D_FF ** -0.5),
    }


def reference(x_prompt, x_sample, cache_k, cache_v, page_table, state_lru_conv, state_lru_h, state_ffn_conv,
              c_prompt, c_sample, g_norm1, g_norm2, w_ada, b_ada, w_in, g_q, g_k, lam_q1, lam_k1, lam_q2, lam_k2,
              g_subln, w_out, conv_lru_w, conv_lru_b, w_rgate, b_rgate, w_igate, b_igate, lru_lambda,
              w_up, conv_ffn_w, conv_ffn_b, w_down):
    bsz, s_len = x_prompt.shape[0], x_prompt.shape[1]
    dbsz, t_len = x_sample.shape[0], x_sample.shape[1]
    dt = x_prompt.dtype
    past_len = page_table.shape[1] * cache_k.shape[2]
    pos_p = jnp.arange(s_len)
    pos_s = past_len + jnp.arange(t_len)
    yp, ys = x_prompt, x_sample
    st_p, st_s = [], []
    for l in range(DEPTH):
        p = {'g_norm1': g_norm1[l], 'g_norm2': g_norm2[l], 'w_ada': w_ada[l], 'b_ada': b_ada[l],
             'w_in': w_in[l], 'g_q': g_q[l], 'g_k': g_k[l], 'lam_q1': lam_q1[l], 'lam_k1': lam_k1[l],
             'lam_q2': lam_q2[l], 'lam_k2': lam_k2[l], 'g_subln': g_subln[l], 'w_out': w_out[l],
             'conv_lru_w': conv_lru_w[l], 'conv_lru_b': conv_lru_b[l], 'w_rgate': w_rgate[l],
             'b_rgate': b_rgate[l], 'w_igate': w_igate[l], 'b_igate': b_igate[l],
             'lru_lambda': lru_lambda[l], 'w_up': w_up[l], 'conv_ffn_w': conv_ffn_w[l],
             'conv_ffn_b': conv_ffn_b[l], 'w_down': w_down[l]}
        lam0 = lambda_init(l)
        yp, sp = layer_forward(yp, c_prompt, pos_p, None,
                               jnp.zeros((bsz, LRU_CONV - 1, LRU_WIDTH), dt),
                               jnp.zeros((bsz, LRU_WIDTH), F32),
                               jnp.zeros((bsz, FFN_CONV - 1, 2 * D_FF), dt), p, lam0)
        k_past = cache_k[l][page_table].reshape(dbsz, past_len, ATT_HEADS, 2, QK_SUB_DIM)
        v_past = cache_v[l][page_table].reshape(dbsz, past_len, ATT_HEADS, V_HEAD_DIM)
        ys, ss = layer_forward(ys, c_sample, pos_s, (k_past, v_past), state_lru_conv[l], state_lru_h[l],
                               state_ffn_conv[l], p, lam0)
        st_p.append(sp)
        st_s.append(ss)
    k_p = jnp.stack([s[0] for s in st_p])
    v_p = jnp.stack([s[1] for s in st_p])
    lc_p = jnp.stack([s[2] for s in st_p])
    h_p = jnp.stack([s[3] for s in st_p])
    fc_p = jnp.stack([s[4] for s in st_p])
    k_s = jnp.stack([s[0] for s in st_s])
    v_s = jnp.stack([s[1] for s in st_s])
    lc_s = jnp.stack([s[2] for s in st_s])
    h_s = jnp.stack([s[3] for s in st_s])
    fc_s = jnp.stack([s[4] for s in st_s])
    return (yp, ys, k_p, v_p, lc_p, h_p, fc_p, k_s, v_s, lc_s, h_s, fc_s)
```

```cpp
#include <hip/hip_runtime.h>
#include <cstdio>
#include <cstdint>
namespace pg8 {
#define PG8_LAS __attribute__((address_space(3)))
typedef unsigned short bf16_t;
typedef short bf16x8 __attribute__((ext_vector_type(8)));
typedef float f32x4 __attribute__((ext_vector_type(4)));
typedef unsigned u32x4 __attribute__((ext_vector_type(4)));
constexpr int BM = 256, BK = 64, HALF = 128, HTB = HALF * BK * 2  , STAGE_BYTES = 8 * HTB, NXCD = 8, WGM = 8;

__host__ __device__ __forceinline__ int lds_byte(int r, int c) { const int st = (r >> 4) * 2 + (c >> 5), rr = r & 15, cc = c & 31, ob = rr * 64 + cc * 2; return st * 1024 + (ob ^ (((ob >> 9) & 1) << 5)); }
__host__ __device__ __forceinline__ void stage_rc(int b, int& R, int& C) { const int st = b / 1024, sb = b % 1024, swz = sb ^ (((sb >> 9) & 1) << 5); R = (st >> 1) * 16 + swz / 64; C = (st & 1) * 32 + (swz % 64) / 2; }
__host__ __device__ __forceinline__ int perm32(int rho) { const int n = rho >> 4, i = rho & 15; return 8 * (i >> 2) + 4 * n + (i & 3); }

struct Unit { int pm, pn; };
struct Gemm { const bf16_t* A; const bf16_t* Bt; int M, N, K; };

struct StaticOrder {
    int nM, nN, nwg, G, c;
    __host__ __device__ void init(int M, int N, int G_, int c_) { nM = M / BM; nN = N / BM; nwg = nM * nN; G = G_; c = c_; }
    __host__ __device__ bool next(int i, Unit& u) const {
        const long L = (long)i * G + c; if (L >= nwg) return false;
        int wgid = (int)L; { const int q = nwg / NXCD, r = nwg % NXCD, xcd = wgid % NXCD, off = wgid / NXCD; wgid = (xcd < r ? xcd * (q + 1) : r * (q + 1) + (xcd - r) * q) + off; }
        const int nig = WGM * nN, gid = wgid / nig, fm = gid * WGM, gsz = (nM - fm) < WGM ? (nM - fm) : WGM;
        u.pm = fm + ((wgid % nig) % gsz); u.pn = (wgid % nig) / gsz; return true;
    }
    __device__ __forceinline__ void a_ready(const Unit&) const {}
    __device__ __forceinline__ void done(const Unit&) const {}
};

__device__ __forceinline__ unsigned cvt_pk_bf16(float lo, float hi) { unsigned r; asm volatile("v_cvt_pk_bf16_f32 %0, %1, %2" : "=v"(r) : "v"(lo), "v"(hi)); return r; }
typedef float f32x2 __attribute__((ext_vector_type(2)));
__device__ __forceinline__ f32x2 gelu_pk(f32x2 v) {
    const f32x2 av = __builtin_elementwise_abs(v), d = av * 0.2316418882f + 1.0f;
    f32x2 t; t.x = __builtin_amdgcn_rcpf(d.x); t.y = __builtin_amdgcn_rcpf(d.y);
    f32x2 q = t * 0.5307027145f + (-0.7265760135f); q = q * t + 0.7107068705f; q = q * t + (-0.142248368f); q = q * t + 0.127414796f; q = q * t;
    const f32x2 s = (v * v) * (-0.72134752044f);
    f32x2 e; e.x = __builtin_amdgcn_exp2f(s.x); e.y = __builtin_amdgcn_exp2f(s.y);
    const f32x2 m = v * (q * e), r = v - m;
    f32x2 o; o.x = v.x < 0.f ? m.x : r.x; o.y = v.y < 0.f ? m.y : r.y; return o;
}

template <int ACT  > struct EpiBf16 {
    static constexpr bool PERM = true, AFTER_DRAIN = false; static_assert(ACT == 0 || ACT == 1, "EpiBf16: ACT is 0 (none) or 1 (gelu_pk)");
    bf16_t* O; int ldc; const float* bias; int split_cols; size_t split_stride; float scale0;
    __device__ __forceinline__ void operator()(const f32x4 (&acc)[2][2][4][2], const Unit& u, int wr, int wc, int fr, int fq) const {
        const int row0 = u.pm * BM + wr * 64 + fr; int colt = u.pn * BM; bf16_t* base = O;
        float sc = 1.f; if (split_cols) { const int t = colt / split_cols; base += (size_t)t * split_stride; colt -= t * split_cols; if (t == 0) sc = scale0; }
        const int col0 = colt + wc * 32 + 8 * fq, bcol0 = u.pn * BM + wc * 32 + 8 * fq;
        f32x4 bv[2][2];
#pragma unroll
        for (int bj = 0; bj < 2; ++bj)
#pragma unroll
            for (int n = 0; n < 2; ++n) bv[bj][n] = bias ? *(const f32x4*)(bias + bcol0 + bj * HALF + 4 * n) : (f32x4){0.f, 0.f, 0.f, 0.f};
#pragma unroll
        for (int ai = 0; ai < 2; ++ai)
#pragma unroll
            for (int m = 0; m < 4; ++m) { bf16_t* rowp = base + (size_t)(row0 + ai * HALF + m * 16) * ldc + col0;
#pragma unroll
                for (int bj = 0; bj < 2; ++bj) { f32x4 v0 = acc[ai][bj][m][0] + bv[bj][0], v1 = acc[ai][bj][m][1] + bv[bj][1];
                    if (ACT == 1) { f32x2 a = gelu_pk((f32x2){v0[0], v0[1]}), b = gelu_pk((f32x2){v0[2], v0[3]}), c = gelu_pk((f32x2){v1[0], v1[1]}), d = gelu_pk((f32x2){v1[2], v1[3]});
                        v0 = (f32x4){a.x, a.y, b.x, b.y}; v1 = (f32x4){c.x, c.y, d.x, d.y}; }
                    v0 = v0 * sc; v1 = v1 * sc; u32x4 w; w.x = cvt_pk_bf16(v0[0], v0[1]); w.y = cvt_pk_bf16(v0[2], v0[3]); w.z = cvt_pk_bf16(v1[0], v1[1]); w.w = cvt_pk_bf16(v1[2], v1[3]);
                    *(u32x4*)(rowp + bj * HALF) = w; } }
    }
};

constexpr int MPROMPT = 16384;
struct EpiF32Bias {
    static constexpr bool PERM = false, AFTER_DRAIN = false;
    float* out; int ldc; const float* bias;
    __device__ __forceinline__ void operator()(const f32x4 (&acc)[2][2][4][2], const Unit& u, int wr, int wc, int fr, int fq) const {
        const int col0 = u.pn * BM + wc * 32 + 4 * fq;
        f32x4 bv[2][2];
#pragma unroll
        for (int bj = 0; bj < 2; ++bj)
#pragma unroll
            for (int n = 0; n < 2; ++n) bv[bj][n] = *(const f32x4*)(bias + col0 + bj * HALF + n * 16);
#pragma unroll
        for (int ai = 0; ai < 2; ++ai)
#pragma unroll
            for (int m = 0; m < 4; ++m) { float* rp = out + (size_t)(u.pm * BM + ai * HALF + wr * 64 + m * 16 + fr) * ldc + col0;
#pragma unroll
                for (int bj = 0; bj < 2; ++bj)
#pragma unroll
                    for (int n = 0; n < 2; ++n) *(f32x4*)(rp + bj * HALF + n * 16) = acc[ai][bj][m][n] + bv[bj][n]; }
    }
};
struct EpiResGate {
    static constexpr bool PERM = false, AFTER_DRAIN = false;
    const float* bp; const float* bs;
    const float* gate;
    float* out;
    __device__ __forceinline__ void operator()(const f32x4 (&acc)[2][2][4][2], const Unit& u, int wr, int wc, int fr, int fq) const {
        const int col0 = u.pn * BM + wc * 32 + 4 * fq;
#pragma unroll
        for (int ai = 0; ai < 2; ++ai)
#pragma unroll
            for (int m = 0; m < 4; ++m) { const int row = u.pm * BM + ai * HALF + wr * 64 + m * 16 + fr;
                const float* b = (row < MPROMPT) ? bp + (size_t)row * 1024 : bs + (size_t)(row - MPROMPT) * 1024;
                const int mr = (row < MPROMPT) ? (row >> 12) : 4 + ((row - MPROMPT) >> 2);
                const float* g = gate + (size_t)mr * 6144; float* o = out + (size_t)row * 1024;
#pragma unroll
                for (int bj = 0; bj < 2; ++bj)
#pragma unroll
                    for (int n = 0; n < 2; ++n) { const int c = col0 + bj * HALF + n * 16; const f32x4 bb = *(const f32x4*)(b + c), gg = *(const f32x4*)(g + c);
                        *(f32x4*)(o + c) = bb + gg * acc[ai][bj][m][n]; }
                if (m & 1) asm volatile("" ::: "memory"); }
    }
};
template <class Epi, class Sched, bool ALIGN_EPI = false, bool SP2 = false>
__device__ __forceinline__ void gemm_phase(PG8_LAS unsigned char* lds, const Gemm g, const Sched& S, const Epi& E) {
    const int tid = threadIdx.x, wid = __builtin_amdgcn_readfirstlane(tid >> 6), lane = tid & 63, wr = wid >> 2, wc = wid & 3, fr = lane & 15, fq = lane >> 4;
    const int K = g.K, nt = K / BK;
    unsigned voffA[2], voffB[2];
#pragma unroll
    for (int i = 0; i < 2; ++i) { int R, C; stage_rc(tid * 16 + i * 8192, R, C); const int Rb = Epi::PERM ? ((R & ~31) + perm32(R & 31)) : R;
        voffA[i] = (unsigned)(R * K + C) * 2u; voffB[i] = (unsigned)(Rb * K + C) * 2u; }
    const size_t kstep = (size_t)(BK * 2);
    const size_t hstep = (size_t)HALF * K * 2;
    const size_t tstep = 2 * hstep;
    const unsigned ldsw = (unsigned)wid * 1024u;
    const int aoff = lds_byte(wr * 64 + fr, fq * 8), boff = lds_byte(wc * 32 + fr, fq * 8);
#define PG8_SA(b, h) (((b) * 2 + (h)) * HTB)
#define PG8_SB(b, h) ((4 + (b) * 2 + (h)) * HTB)
#define PG8_STAGE(bufoff, gbase, voff) do { _Pragma("unroll") for (int _i = 0; _i < 2; ++_i) \
        __builtin_amdgcn_global_load_lds((const unsigned*)((const char*)(gbase) + (voff)[_i]), (PG8_LAS unsigned*)(lds + (bufoff) + ldsw + _i * 8192), 16, 0, 0); } while (0)
#define PG8_LDA(dst, b, h) do { _Pragma("unroll") for (int m = 0; m < 4; ++m) _Pragma("unroll") for (int k = 0; k < 2; ++k) dst[m][k] = *(const PG8_LAS bf16x8*)(lds + PG8_SA(b, h) + aoff + m * 2048 + k * 1024); } while (0)
#define PG8_LDB(dst, b, h) do { _Pragma("unroll") for (int n = 0; n < 2; ++n) _Pragma("unroll") for (int k = 0; k < 2; ++k) dst[n][k] = *(const PG8_LAS bf16x8*)(lds + PG8_SB(b, h) + boff + n * 2048 + k * 1024); } while (0)
#define PG8_MMA(ai, bj, At, Bt) do { __builtin_amdgcn_s_setprio(1); _Pragma("unroll") for (int m = 0; m < 4; ++m) _Pragma("unroll") for (int n = 0; n < 2; ++n) _Pragma("unroll") for (int k = 0; k < 2; ++k) \
        acc[ai][bj][m][n] = __builtin_amdgcn_mfma_f32_16x16x32_bf16(Bt[n][k], At[m][k], acc[ai][bj][m][n], 0, 0, 0); __builtin_amdgcn_s_setprio(0); } while (0)
#define PG8_WAIT_V(n) asm volatile("s_waitcnt vmcnt(" #n ")" ::: "memory")
#define PG8_WAIT_L(n) asm volatile("s_waitcnt lgkmcnt(" #n ")" ::: "memory")
#define PG8_BAR __builtin_amdgcn_s_barrier()
#define PG8_SCHED __builtin_amdgcn_sched_barrier(0)
    Unit cur, nxt; int ui = 0;
    if (!S.next(0, cur)) return;
    f32x4 acc[2][2][4][2];
#pragma unroll
    for (int a = 0; a < 2; ++a)
#pragma unroll
        for (int b = 0; b < 2; ++b)
#pragma unroll
            for (int m = 0; m < 4; ++m)
#pragma unroll
                for (int n = 0; n < 2; ++n) acc[a][b][m][n] = (f32x4){0.f, 0.f, 0.f, 0.f};
    bf16x8 At[4][2], B0[2][2], B1[2][2];
    const char* cA = (const char*)g.A + (size_t)cur.pm * tstep; const char* cB = (const char*)g.Bt + (size_t)cur.pn * tstep;
    S.a_ready(cur);
    if constexpr (SP2) {
        PG8_STAGE(PG8_SB(0, 0), cB, voffB); PG8_STAGE(PG8_SB(0, 1), cB + hstep, voffB); PG8_STAGE(PG8_SA(0, 0), cA, voffA); PG8_STAGE(PG8_SA(0, 1), cA + hstep, voffA);
        if (wr == 1) PG8_BAR;
        PG8_WAIT_V(2); PG8_BAR;
        PG8_STAGE(PG8_SB(1, 0), cB + kstep, voffB); PG8_STAGE(PG8_SA(1, 0), cA + kstep, voffA); PG8_STAGE(PG8_SB(1, 1), cB + hstep + kstep, voffB);
        PG8_WAIT_V(6); PG8_BAR;
    } else {
        PG8_STAGE(PG8_SB(0, 0), cB, voffB); PG8_STAGE(PG8_SA(0, 0), cA, voffA); PG8_STAGE(PG8_SB(0, 1), cB + hstep, voffB); PG8_STAGE(PG8_SA(0, 1), cA + hstep, voffA);
        if (wr == 1) PG8_BAR;
        PG8_WAIT_V(4); PG8_BAR;
        PG8_STAGE(PG8_SB(1, 0), cB + kstep, voffB); PG8_STAGE(PG8_SA(1, 0), cA + kstep, voffA); PG8_STAGE(PG8_SB(1, 1), cB + hstep + kstep, voffB);
        PG8_WAIT_V(6); PG8_BAR;
    }
    for (;;) {
        const bool has_next = S.next(ui + 1, nxt);
        const char* nA = has_next ? (const char*)g.A + (size_t)nxt.pm * tstep : cA; const char* nB = has_next ? (const char*)g.Bt + (size_t)nxt.pn * tstep : cB;
        for (int t = 0; t < nt; t += 2) {
            const bool last = (t == nt - 2);
            const char* a1 = cA + (size_t)(t + 1) * kstep;
            const char* a2 = last ? nA : cA + (size_t)(t + 2) * kstep; const char* b2 = last ? nB : cB + (size_t)(t + 2) * kstep;
            const char* a3 = a2 + kstep; const char* b3 = b2 + kstep;
            if (last && has_next) S.a_ready(nxt);
            if constexpr (SP2) {
            PG8_LDB(B0, 0, 0); PG8_LDB(B1, 0, 1); PG8_SCHED; PG8_LDA(At, 0, 0); PG8_STAGE(PG8_SA(1, 1), a1 + hstep, voffA);
            PG8_WAIT_V(8); PG8_WAIT_L(0); PG8_BAR; PG8_MMA(0, 0, At, B0); PG8_MMA(0, 1, At, B1); PG8_BAR; PG8_SCHED;
            PG8_LDA(At, 0, 1); PG8_STAGE(PG8_SB(0, 0), b2, voffB); PG8_STAGE(PG8_SB(0, 1), b2 + hstep, voffB); PG8_STAGE(PG8_SA(0, 0), a2, voffA);
            PG8_WAIT_V(8); PG8_WAIT_L(0); PG8_BAR; PG8_MMA(1, 0, At, B0); PG8_MMA(1, 1, At, B1); PG8_BAR; PG8_SCHED;
            PG8_LDB(B0, 1, 0); PG8_LDB(B1, 1, 1); PG8_SCHED; PG8_LDA(At, 1, 0); PG8_STAGE(PG8_SA(0, 1), a2 + hstep, voffA);
            PG8_WAIT_V(8); PG8_WAIT_L(0); PG8_BAR; PG8_MMA(0, 0, At, B0); PG8_MMA(0, 1, At, B1); PG8_BAR; PG8_SCHED;
            PG8_LDA(At, 1, 1); PG8_STAGE(PG8_SB(1, 0), b3, voffB); PG8_STAGE(PG8_SB(1, 1), b3 + hstep, voffB); PG8_STAGE(PG8_SA(1, 0), a3, voffA);
            PG8_WAIT_V(8); PG8_WAIT_L(0); PG8_BAR; PG8_MMA(1, 0, At, B0); PG8_MMA(1, 1, At, B1); PG8_BAR; PG8_SCHED;
            } else {
            PG8_LDB(B0, 0, 0); PG8_SCHED; PG8_LDA(At, 0, 0); PG8_STAGE(PG8_SA(1, 1), a1 + hstep, voffA);
            PG8_WAIT_L(8); PG8_BAR; PG8_WAIT_L(0); PG8_MMA(0, 0, At, B0); PG8_BAR; PG8_SCHED;
            PG8_LDB(B1, 0, 1); PG8_STAGE(PG8_SB(0, 0), b2, voffB);
            PG8_BAR; PG8_WAIT_L(0); PG8_MMA(0, 1, At, B1); PG8_BAR;
            PG8_LDA(At, 0, 1); PG8_STAGE(PG8_SA(0, 0), a2, voffA);
            PG8_BAR; PG8_WAIT_L(0); PG8_MMA(1, 0, At, B0); PG8_BAR; PG8_SCHED;
            PG8_STAGE(PG8_SB(0, 1), b2 + hstep, voffB);
            PG8_WAIT_V(6); PG8_BAR; PG8_MMA(1, 1, At, B1); PG8_BAR;
            PG8_LDB(B0, 1, 0); PG8_SCHED; PG8_LDA(At, 1, 0); PG8_STAGE(PG8_SA(0, 1), a2 + hstep, voffA);
            PG8_WAIT_L(8); PG8_BAR; PG8_WAIT_L(0); PG8_MMA(0, 0, At, B0); PG8_BAR; PG8_SCHED;
            PG8_LDB(B1, 1, 1); PG8_STAGE(PG8_SB(1, 0), b3, voffB);
            PG8_BAR; PG8_WAIT_L(0); PG8_MMA(0, 1, At, B1); PG8_BAR;
            PG8_LDA(At, 1, 1); PG8_STAGE(PG8_SA(1, 0), a3, voffA);
            PG8_BAR; PG8_WAIT_L(0); PG8_MMA(1, 0, At, B0); PG8_BAR; PG8_SCHED;
            PG8_STAGE(PG8_SB(1, 1), b3 + hstep, voffB);
            PG8_WAIT_V(6); PG8_BAR; PG8_MMA(1, 1, At, B1); PG8_BAR;
            }
        }
        if constexpr (ALIGN_EPI) { if (wr == 0) PG8_BAR; }
        if constexpr (!Epi::AFTER_DRAIN) { E(acc, cur, wr, wc, fr, fq); S.done(cur); }
        if (!has_next) break;
#pragma unroll
        for (int a = 0; a < 2; ++a)
#pragma unroll
            for (int b = 0; b < 2; ++b)
#pragma unroll
                for (int m = 0; m < 4; ++m)
#pragma unroll
                    for (int n = 0; n < 2; ++n) acc[a][b][m][n] = (f32x4){0.f, 0.f, 0.f, 0.f};
        cur = nxt; cA = nA; cB = nB; ++ui;
        if constexpr (ALIGN_EPI) { if (wr == 1) PG8_BAR; }
    }
    PG8_WAIT_V(0);
    if constexpr (!ALIGN_EPI) { if (wr == 0) PG8_BAR; }
    PG8_BAR;
    if constexpr (Epi::AFTER_DRAIN) { E.fused(acc, cur, wr, wc, fr, fq, lds, wid, lane); S.done(cur); }
#undef PG8_SA
#undef PG8_SB
#undef PG8_STAGE
#undef PG8_LDA
#undef PG8_LDB
#undef PG8_MMA
#undef PG8_WAIT_V
#undef PG8_WAIT_L
#undef PG8_BAR
#undef PG8_SCHED
}
}

#ifndef PG8_SP2
#define PG8_SP2 true
#endif
#ifndef PG8_ALIGN
#define PG8_ALIGN true
#endif
#include <hip/hip_bf16.h>
#include <cmath>
namespace attn_body {
using bf16=__hip_bfloat16;
using bf16x8=__attribute__((ext_vector_type(8)))short;
using s16x4=__attribute__((ext_vector_type(4)))short;
using f32x16=__attribute__((ext_vector_type(16)))float;
using u32x4=__attribute__((ext_vector_type(4)))unsigned;
constexpr int SEQ=4096,D=64; constexpr int QP=512,KP=512,VP=2560,OP=1024;
constexpr int NW=8,QBLK=32,QB=QBLK*NW,KVBLK=64,NQB=SEQ/QB;
constexpr int ATTN_UNIT_ROWS=QB;
__device__ __forceinline__ int crow(int r,int hi){return (r&3)+8*(r>>2)+4*hi;}
#define SBAR() __builtin_amdgcn_sched_barrier(0)
__device__ __forceinline__ void cmask(f32x16&p0,f32x16&p1,int jb,int qrel,int hi){
  const float NEG=-INFINITY; int kb=64*jb+4*hi;
  #pragma unroll
  for(int r=0;r<16;++r){int kv=kb+(r&3)+8*(r>>2); if(kv>qrel)p0[r]=NEG; if(kv+32>qrel)p1[r]=NEG;}
}

constexpr int NSLOT=3, SLOTB=8192;
constexpr int LDS_K=0, LDS_V=NSLOT*SLOTB, LDS_WS=2*NSLOT*SLOTB, LDS_OST=LDS_WS+NW*64*4, LDS_BYTES=LDS_OST+NW*4096;
constexpr float C2=0.125f*1.4426950408889634f;
__device__ __forceinline__ void glds16(const void*gsrc,unsigned lds_dst){unsigned keep;
  asm volatile("s_mov_b32 %0, m0\n\ts_mov_b32 m0, %2\n\ts_nop 0\n\tglobal_load_lds_dwordx4 %1, off\n\ts_mov_b32 m0, %0":"=&s"(keep):"v"(gsrc),"s"(lds_dst):"memory");}
__device__ __forceinline__ float max3f(float a,float b,float c){float r;asm("v_max3_f32 %0, %1, %2, %3":"=v"(r):"v"(a),"v"(b),"v"(c));return r;}
__device__ __forceinline__ float max2f(float a,float b){float r;asm("v_max_f32_e32 %0, %1, %2":"=v"(r):"v"(a),"v"(b));return r;}
__device__ __forceinline__ float fadd_s(float a,float b){float r;asm("v_add_f32_e32 %0, %1, %2":"=v"(r):"v"(a),"v"(b));return r;}
__device__ __forceinline__ float fsub_s(float a,float b){float r;asm("v_sub_f32_e32 %0, %1, %2":"=v"(r):"v"(a),"v"(b));return r;}
typedef float f32x2_t __attribute__((ext_vector_type(2))); typedef __bf16 bf16x2_t __attribute__((ext_vector_type(2)));
__device__ __forceinline__ unsigned cvtpk_s(float lo,float hi){f32x2_t v={lo,hi};bf16x2_t b=__builtin_convertvector(v,bf16x2_t);return __builtin_bit_cast(unsigned,b);}
#define WAIT_BAR(N) asm volatile("s_waitcnt vmcnt(" #N ") lgkmcnt(0)\n\ts_barrier":::"memory")

__device__ __forceinline__ void qkt(f32x16&p0,f32x16&p1,const char*Kslot,const bf16x8*qr,const f32x16&negm,int r32,int hi){
  const char*kb=Kslot+hi*1024+r32*16;
  #pragma unroll
  for(int d0=0;d0<4;++d0){
    const bf16x8 b0=*reinterpret_cast<const bf16x8*>(kb+d0*2048);
    const bf16x8 b1=*reinterpret_cast<const bf16x8*>(kb+d0*2048+512);
    if(d0==0){p0=__builtin_amdgcn_mfma_f32_32x32x16_bf16(b0,qr[0],negm,0,0,0);p1=__builtin_amdgcn_mfma_f32_32x32x16_bf16(b1,qr[0],negm,0,0,0);}
    else{p0=__builtin_amdgcn_mfma_f32_32x32x16_bf16(b0,qr[d0],p0,0,0,0);p1=__builtin_amdgcn_mfma_f32_32x32x16_bf16(b1,qr[d0],p1,0,0,0);}}
}
typedef __attribute__((address_space(3))) const char* lds_cptr;
typedef short v4i16_t __attribute__((ext_vector_type(4)));
__device__ __forceinline__ void kload8(bf16x8*kf,lds_cptr kp){
  kf[0]=*(const __attribute__((address_space(3))) bf16x8*)(kp);      kf[1]=*(const __attribute__((address_space(3))) bf16x8*)(kp+512);
  kf[2]=*(const __attribute__((address_space(3))) bf16x8*)(kp+2048); kf[3]=*(const __attribute__((address_space(3))) bf16x8*)(kp+2560);
  kf[4]=*(const __attribute__((address_space(3))) bf16x8*)(kp+4096); kf[5]=*(const __attribute__((address_space(3))) bf16x8*)(kp+4608);
  kf[6]=*(const __attribute__((address_space(3))) bf16x8*)(kp+6144); kf[7]=*(const __attribute__((address_space(3))) bf16x8*)(kp+6656);
}
__device__ __forceinline__ void kload2(bf16x8*kf,lds_cptr kp,int j){ kf[2*j]=*(const __attribute__((address_space(3))) bf16x8*)(kp+j*2048); kf[2*j+1]=*(const __attribute__((address_space(3))) bf16x8*)(kp+j*2048+512); }
__device__ __forceinline__ s16x4 vtr(lds_cptr p){ return __builtin_bit_cast(s16x4,__builtin_amdgcn_ds_read_tr16_b64_v4i16((__attribute__((address_space(3))) v4i16_t*)p)); }
__device__ __forceinline__ float rowmax(const f32x16&p0,const f32x16&p1){
  float a=max3f(p0[0],p0[1],p1[0]),b=max3f(p0[2],p0[3],p1[1]);a=max3f(a,p1[2],p1[3]);
  #pragma unroll
  for(int r=4;r<16;r+=4){a=max3f(a,p0[r],p0[r+1]);b=max3f(b,p0[r+2],p0[r+3]);a=max3f(a,p1[r],p1[r+1]);b=max3f(b,p1[r+2],p1[r+3]);}
  const float m=max2f(a,b);
  auto rr=__builtin_amdgcn_permlane32_swap(__float_as_uint(m),__float_as_uint(m),false,false);
  return max2f(__uint_as_float(rr[0]),__uint_as_float(rr[1]));
}
__device__ __forceinline__ void pv(f32x16*o,int vb,bf16x8 pa0,bf16x8 pa1,bf16x8 pa2,bf16x8 pa3){
  #pragma unroll
  for(int d0=0;d0<2;++d0){s16x4 lo[4],hi[4];
    #pragma unroll
    for(int ks=0;ks<4;++ks){
      asm volatile("ds_read_b64_tr_b16 %0,%1 offset:%c2":"=&v"(lo[ks]):"v"(vb),"i"(d0*4096+ks*1024):"memory");
      asm volatile("ds_read_b64_tr_b16 %0,%1 offset:%c2":"=&v"(hi[ks]):"v"(vb),"i"(d0*4096+ks*1024+512):"memory");}
    asm volatile("s_waitcnt lgkmcnt(0)":::"memory");SBAR();
    #define PK(k) (bf16x8){lo[k][0],lo[k][1],lo[k][2],lo[k][3],hi[k][0],hi[k][1],hi[k][2],hi[k][3]}
    o[d0]=__builtin_amdgcn_mfma_f32_32x32x16_bf16(pa0,PK(0),o[d0],0,0,0);
    o[d0]=__builtin_amdgcn_mfma_f32_32x32x16_bf16(pa1,PK(1),o[d0],0,0,0);
    o[d0]=__builtin_amdgcn_mfma_f32_32x32x16_bf16(pa2,PK(2),o[d0],0,0,0);
    o[d0]=__builtin_amdgcn_mfma_f32_32x32x16_bf16(pa3,PK(3),o[d0],0,0,0);
    #undef PK
  }
}

#ifndef ATTN_STORE16
#define ATTN_STORE16(p,v) (*(u32x4*)(p)=(v))
#endif
template<int THRL> __device__ __forceinline__ void attn_unit(int b,int qb,const bf16*Q,const bf16*__restrict__ K,const bf16*__restrict__ V,bf16*O,char*shm){
  const int tid=threadIdx.x,lane=tid&63,r32=lane&31,hi=lane>>5; const int wid=__builtin_amdgcn_readfirstlane(tid>>6);
  const long rowbase=(long)b*SEQ; const int q0=qb*QB;
  const bf16*Qw=Q+(rowbase+q0+wid*QBLK)*QP;
  const bf16*Kh=K+rowbase*KP,*Vh=V+rowbase*VP;
  const unsigned lds0=(unsigned)(uintptr_t)shm;
  float*wsf=(float*)(shm+LDS_WS)+wid*64;
  const bf16*ksrc=Kh+(long)lane*KP+wid*8;
  const bf16*vsrc=Vh+(long)(16*(wid&3)+(lane>>2))*VP+(wid>>2)*32+(lane&3)*8;
  const unsigned kdst=lds0+LDS_K+wid*1024, vdst=lds0+LDS_V+wid*1024;
  #define DMA_K(t,slot) glds16(ksrc+(long)(t)*KVBLK*KP,(unsigned)__builtin_amdgcn_readfirstlane(kdst+(slot)))
  #define DMA_V(t,slot) glds16(vsrc+(long)(t)*KVBLK*VP,(unsigned)__builtin_amdgcn_readfirstlane(vdst+(slot)))
  const int vb0=(int)(lds0+LDS_V)+((lane>>4)&1)*32+(lane&3)*8+(4*hi+((lane&15)>>2))*64;
  const char*Kbase=shm+LDS_K; bf16x8 kf[8];
  const lds_cptr shm3=(lds_cptr)shm; const lds_cptr kp0=shm3+LDS_K+hi*1024+r32*16; const lds_cptr vp0=shm3+LDS_V+((lane>>4)&1)*32+(lane&3)*8+(4*hi+((lane&15)>>2))*64;
  const int NT=(q0+QB)/KVBLK;
  DMA_K(0,0);DMA_V(0,0);DMA_K(1,SLOTB);
  bf16x8 qr[4];
  #pragma unroll
  for(int d0=0;d0<4;++d0)qr[d0]=*reinterpret_cast<const bf16x8*>(&Qw[(long)r32*QP+d0*16+hi*8]);
  float mhat=0.f,l_reg=0.f;f32x16 o[2];f32x16 negm; { float z_=0.f; asm volatile("":"+v"(z_)); _Pragma("unroll") for(int r=0;r<16;++r){o[0][r]=z_;o[1][r]=z_;negm[r]=z_;} } asm volatile("":"+v"(negm));
  const int qrel=wid*QBLK+r32;
  #define CMASK(P0,P1,t) do{int jb_=(t)-(NT-4); if(jb_>=0)cmask(P0,P1,jb_,qrel,hi);}while(0)
  bool resc=false;
  #define START(P0,P1) do{ const float rm=rowmax(P0,P1); resc=false; \
    { const float dl=rm; mhat=fadd_s(mhat,dl); \
      _Pragma("unroll") for(int r=0;r<16;++r){P0[r]=fsub_s(P0[r],dl);P1[r]=fsub_s(P1[r],dl);} \
      _Pragma("unroll") for(int r=0;r<16;++r)negm[r]=-mhat; asm volatile("":"+v"(negm)); } \
    _Pragma("unroll") for(int r=0;r<16;++r)P0[r]=__builtin_amdgcn_exp2f(P0[r]); }while(0)
  #define RESC() do{ if(resc){ asm volatile("s_waitcnt lgkmcnt(0)":::"memory"); \
      _Pragma("unroll") for(int d_=0;d_<2;++d_) _Pragma("unroll") for(int r=0;r<16;++r)o[d_][r]*=wsf[crow(r,hi)]; } }while(0)
  f32x16 pA0,pA1,pB0,pB1;
  int sl_prev=0,sl_cur=0,sl_next=SLOTB;
  #define ROT() do{sl_prev=sl_cur;sl_cur=sl_next;sl_next=(sl_next==(NSLOT-1)*SLOTB)?0:sl_next+SLOTB;}while(0)
  DMA_K(2,2*SLOTB);
  WAIT_BAR(3);
  qkt(pA0,pA1,Kbase,qr,negm,r32,hi);asm volatile("s_nop 15\n\ts_nop 7":"+v"(pA0),"+v"(pA1));CMASK(pA0,pA1,0);
  START(pA0,pA1);
  _Pragma("unroll") for(int r=0;r<16;++r)pA1[r]=__builtin_amdgcn_exp2f(pA1[r]);
  WAIT_BAR(0);
  DMA_K(3,0);DMA_V(1,SLOTB);
  ROT();
  kload8(kf,kp0+sl_cur);
  WAIT_BAR(2);
  s16x4 vlo[8],vhi[8]; u32x4 pw0,pw1,pw2,pw3;
  #define PKW(P,B) cvtpk_s(P[B],P[B+1])
  #define PAF(k) __builtin_bit_cast(bf16x8,pw##k)
  #define VFR(i) (bf16x8){vlo[i][0],vlo[i][1],vlo[i][2],vlo[i][3],vhi[i][0],vhi[i][1],vhi[i][2],vhi[i][3]}
  #define PIN(x) asm volatile("":"+v"(x))
  #define MX3(a,b,c) __builtin_fmaxf(__builtin_fmaxf((a),(b)),(c))
  #define GAPA(MF,A0,A1,A2,A3,W0,W1,PW) do{ MF; sacc+=A0; sacc+=A1; sacc+=A2; sacc+=A3; PIN(sacc); W0; W1; PIN(PW); SBAR(); }while(0)
  #define EX(v) __builtin_amdgcn_exp2f(v)
  #define GAPB(MF,X,B) do{ MF; X[B]=EX(X[B]); X[B+1]=EX(X[B+1]); X[B+2]=EX(X[B+2]); X[B+3]=EX(X[B+3]); PIN(X); SBAR(); }while(0)
  #define VRD(i) do{ vlo[i]=vtr(vp_+(((i)>>2)*4096+((i)&3)*1024)); vhi[i]=vtr(vp_+(((i)>>2)*4096+((i)&3)*1024+512)); }while(0)
  #define KRD(G,j) do{ if(G){ kload2(kf,kp0+sl_next,j); SBAR(); } }while(0)
  #define STEP(C0,C1,P0,P1,t,GK,GV,GL) do{ SBAR(); \
    const lds_cptr vp_=vp0+sl_prev; \
    VRD(0); SBAR(); float sacc=(P0[0]+P0[1]); \
    GAPA(C0=__builtin_amdgcn_mfma_f32_32x32x16_bf16(kf[0],qr[0],negm,0,0,0), P0[2],P0[3],P0[4],P0[5],     pw0[0]=PKW(P0,0), pw0[1]=PKW(P0,2), pw0); \
    VRD(4); SBAR(); GAPA(C1=__builtin_amdgcn_mfma_f32_32x32x16_bf16(kf[1],qr[0],negm,0,0,0), P0[6],P0[7],P0[8],P0[9],     pw0[2]=PKW(P0,4), pw0[3]=PKW(P0,6), pw0); \
    VRD(1); SBAR(); GAPA(C0=__builtin_amdgcn_mfma_f32_32x32x16_bf16(kf[2],qr[1],C0,0,0,0),   P0[10],P0[11],P0[12],P0[13], pw1[0]=PKW(P0,8), pw1[1]=PKW(P0,10), pw1); \
    VRD(5); SBAR(); GAPA(C1=__builtin_amdgcn_mfma_f32_32x32x16_bf16(kf[3],qr[1],C1,0,0,0),   P0[14],P0[15],P1[0],P1[1],   pw1[2]=PKW(P0,12),pw1[3]=PKW(P0,14), pw1); \
    VRD(2); SBAR(); GAPA(C0=__builtin_amdgcn_mfma_f32_32x32x16_bf16(kf[4],qr[2],C0,0,0,0),   P1[2],P1[3],P1[4],P1[5],     pw2[0]=PKW(P1,0), pw2[1]=PKW(P1,2), pw2); \
    VRD(6); SBAR(); GAPA(C1=__builtin_amdgcn_mfma_f32_32x32x16_bf16(kf[5],qr[2],C1,0,0,0),   P1[6],P1[7],P1[8],P1[9],     pw2[2]=PKW(P1,4), pw2[3]=PKW(P1,6), pw2); \
    VRD(3); SBAR(); GAPA(C0=__builtin_amdgcn_mfma_f32_32x32x16_bf16(kf[6],qr[3],C0,0,0,0),   P1[10],P1[11],P1[12],P1[13], pw3[0]=PKW(P1,8), pw3[1]=PKW(P1,10), pw3); \
    VRD(7); SBAR(); GAPA(C1=__builtin_amdgcn_mfma_f32_32x32x16_bf16(kf[7],qr[3],C1,0,0,0),   P1[14],P1[15],0.f,0.f,       pw3[2]=PKW(P1,12),pw3[3]=PKW(P1,14), pw3); \
    l_reg+=sacc; \
    if(GK){DMA_K((t)+3,sl_cur);} if(GV){DMA_V((t)+1,sl_next);} \
    CMASK(C0,C1,t); \
    { float a=MX3(C0[0],C0[1],C1[0]),b=MX3(C0[2],C0[3],C1[1]); a=MX3(a,C1[2],C1[3]); \
      _Pragma("unroll") for(int r=4;r<16;r+=4){a=MX3(a,C0[r],C0[r+1]);b=MX3(b,C0[r+2],C0[r+3]);a=MX3(a,C1[r],C1[r+1]);b=MX3(b,C1[r+2],C1[r+3]);} \
      float rm=__builtin_fmaxf(a,b); { auto rr=__builtin_amdgcn_permlane32_swap(__float_as_uint(rm),__float_as_uint(rm),false,false); rm=__builtin_fmaxf(__uint_as_float(rr[0]),__uint_as_float(rr[1])); } \
      resc=false; \
      if(__builtin_expect(__any(rm>(float)THRL),0)){ const float dl=__builtin_fmaxf(rm,0.f); mhat+=dl; \
        _Pragma("unroll") for(int r=0;r<16;++r){C0[r]-=dl;C1[r]-=dl;} \
        _Pragma("unroll") for(int r=0;r<16;++r)negm[r]=-mhat; asm volatile("":"+v"(negm)); \
        const float f=__builtin_amdgcn_exp2f(-dl); l_reg*=f; if(hi==0)wsf[r32]=f; resc=true; } } \
    SBAR(); \
    GAPB(o[0]=__builtin_amdgcn_mfma_f32_32x32x16_bf16(PAF(0),VFR(0),o[0],0,0,0), C0,0); \
    GAPB(o[1]=__builtin_amdgcn_mfma_f32_32x32x16_bf16(PAF(0),VFR(4),o[1],0,0,0), C0,4); \
    KRD(GL,0); GAPB(o[0]=__builtin_amdgcn_mfma_f32_32x32x16_bf16(PAF(1),VFR(1),o[0],0,0,0), C0,8); \
    KRD(GL,1); GAPB(o[1]=__builtin_amdgcn_mfma_f32_32x32x16_bf16(PAF(1),VFR(5),o[1],0,0,0), C0,12); \
    KRD(GL,2); GAPB(o[0]=__builtin_amdgcn_mfma_f32_32x32x16_bf16(PAF(2),VFR(2),o[0],0,0,0), C1,0); \
    KRD(GL,3); GAPB(o[1]=__builtin_amdgcn_mfma_f32_32x32x16_bf16(PAF(2),VFR(6),o[1],0,0,0), C1,4); \
    GAPB(o[0]=__builtin_amdgcn_mfma_f32_32x32x16_bf16(PAF(3),VFR(3),o[0],0,0,0), C1,8); \
    GAPB(o[1]=__builtin_amdgcn_mfma_f32_32x32x16_bf16(PAF(3),VFR(7),o[1],0,0,0), C1,12); \
    }while(0)
  int t=1;
  #undef CMASK
  #define CMASK(P0,P1,t) do{}while(0)
  for(;t+5<NT;t+=2){
    STEP(pB0,pB1,pA0,pA1,t,true,true,true);     WAIT_BAR(2); RESC(); ROT();
    STEP(pA0,pA1,pB0,pB1,t+1,true,true,true);   WAIT_BAR(2); RESC(); ROT();
  }
  #undef CMASK
  #define CMASK(P0,P1,t) do{int jb_=(t)-(NT-4); if(jb_>=0)cmask(P0,P1,jb_,qrel,hi);}while(0)
  #define ENDW(tt) do{ if((tt)+3<NT){WAIT_BAR(2);} else if((tt)+2<NT){WAIT_BAR(1);} else {WAIT_BAR(0);} }while(0)
  for(;t+1<NT;t+=2){
    STEP(pB0,pB1,pA0,pA1,t,(t+3<NT),(t+1<NT),(t+1<NT));       ENDW(t);   RESC(); ROT();
    STEP(pA0,pA1,pB0,pB1,t+1,(t+4<NT),(t+2<NT),(t+2<NT));     ENDW(t+1); RESC(); ROT();
  }
  STEP(pB0,pB1,pA0,pA1,NT-1,false,false,false); RESC();
  { float sacc=pB0[0]+pB0[1]; _Pragma("unroll") for(int r=2;r<16;++r)sacc+=pB0[r]; _Pragma("unroll") for(int r=0;r<16;++r)sacc+=pB1[r]; l_reg+=sacc;
    pw0=(u32x4){PKW(pB0,0),PKW(pB0,2),PKW(pB0,4),PKW(pB0,6)};pw1=(u32x4){PKW(pB0,8),PKW(pB0,10),PKW(pB0,12),PKW(pB0,14)};pw2=(u32x4){PKW(pB1,0),PKW(pB1,2),PKW(pB1,4),PKW(pB1,6)};pw3=(u32x4){PKW(pB1,8),PKW(pB1,10),PKW(pB1,12),PKW(pB1,14)};
    SBAR(); pv(o,vb0+sl_cur,PAF(0),PAF(1),PAF(2),PAF(3)); }
  #undef PKW
  #undef PAF
  #undef VFR
  #undef PIN
  #undef MX3
  #undef GAPA
  #undef GAPB
  #undef EX
  #undef VRD
  #undef KRD
  #undef STEP
  #undef ENDW
  {auto rr=__builtin_amdgcn_permlane32_swap(__float_as_uint(l_reg),__float_as_uint(l_reg),false,false);l_reg=__uint_as_float(rr[0])+__uint_as_float(rr[1]);}
  if(hi==0)wsf[32+r32]=l_reg;asm volatile("s_waitcnt lgkmcnt(0)":::"memory");
  float rli[16];
  #pragma unroll
  for(int r=0;r<16;++r)rli[r]=__builtin_amdgcn_rcpf(wsf[32+crow(r,hi)]);
  bf16*Ow=O+(rowbase+q0+wid*QBLK)*OP;
  { bf16*stg=(bf16*)(shm+LDS_OST)+wid*2048;
    #pragma unroll
    for(int r=0;r<16;++r){const int orow=crow(r,hi);
      #pragma unroll
      for(int d0=0;d0<2;++d0)stg[orow*64+d0*32+r32]=__float2bfloat16(o[d0][r]*rli[r]);}
    asm volatile("s_waitcnt lgkmcnt(0)":::"memory");
    #pragma unroll
    for(int i=0;i<4;++i){const int row=i*8+(lane>>3),ch=lane&7; const u32x4 v=*(const u32x4*)(stg+row*64+ch*8); ATTN_STORE16(Ow+(long)row*OP+ch*8,v);} }
  asm volatile("s_waitcnt lgkmcnt(0)\n\ts_barrier":::"memory");
  #undef DMA_K
  #undef DMA_V
  #undef CMASK
  #undef START
  #undef RESC
  #undef ROT
}
constexpr int ATTN_LDS_BYTES=LDS_BYTES;
#undef SBAR
#undef WAIT_BAR
}
#define GAS __attribute__((address_space(1)))
#define LAS __attribute__((address_space(3)))
typedef unsigned short bf16;
typedef unsigned v4u __attribute__((ext_vector_type(4)));
typedef float f32x4 __attribute__((ext_vector_type(4)));
typedef short bf16x8 __attribute__((ext_vector_type(8)));
typedef GAS unsigned gu32;
typedef GAS unsigned long long gu64;
#define RLX_AGENT __ATOMIC_RELAXED, __HIP_MEMORY_SCOPE_AGENT
#define LDS_WAIT() asm volatile("s_waitcnt lgkmcnt(0)" ::: "memory")
#define VM_WAIT() asm volatile("s_waitcnt vmcnt(0)" ::: "memory")
__device__ __forceinline__ unsigned long long rt() { return __builtin_amdgcn_s_memrealtime(); }
__device__ __forceinline__ unsigned f2bf(float f) { unsigned u = __builtin_bit_cast(unsigned, f); return (u + 0x7fffu + ((u >> 16) & 1u)) >> 16; }
__device__ __forceinline__ unsigned pk2(float lo, float hi) { return f2bf(lo) | (f2bf(hi) << 16); }

#define XB_TMO      128
#define XB_XCNT(j)  (256  + 64 * (j))
#define XB_XSUB(j)  (1280 + 64 * (j))
#define XB_XGEN(j)  (2304 + 64 * (j))
#define XB_TOP      3328
#define XB_TOPGEN   3392
#define XCD_BAR_WORDS 3456
#define XB_SPIN_CAP (1u << 18)

__device__ __forceinline__ unsigned xb_ld(unsigned* p)              { return __hip_atomic_load(p, __ATOMIC_RELAXED, __HIP_MEMORY_SCOPE_AGENT); }
__device__ __forceinline__ unsigned xb_add(unsigned* p, unsigned v) { return __hip_atomic_fetch_add(p, v, __ATOMIC_RELAXED, __HIP_MEMORY_SCOPE_AGENT); }
__device__ __forceinline__ unsigned xb_xcc_id() { return (unsigned)__builtin_amdgcn_s_getreg((3 << 11) | 20) & 0xFu; }
#define XB_SPIN(cond, bar) do { unsigned _sp = 0; while (cond) { __builtin_amdgcn_s_sleep(1); \
    if ((++_sp & 255u) == 0u) { if (xb_ld(&(bar)[XB_TMO])) break; if (_sp > XB_SPIN_CAP) { atomicAdd(&(bar)[XB_TMO], 1u); break; } } } } while (0)

struct XcdBarrier {
    unsigned* bar; unsigned x;
    volatile LAS unsigned* st;
};

__device__ __forceinline__ XcdBarrier xcd_barrier_post(unsigned* bar, volatile LAS unsigned* st) {
    XcdBarrier b; b.bar = bar; b.x = xb_xcc_id(); b.st = st;
    if (threadIdx.x == 0) (void)xb_add(&bar[XB_XCNT(b.x)], 1u);
    return b;
}
__device__ __forceinline__ void xcd_barrier_complete(unsigned* bar, unsigned x, unsigned& nloc, unsigned& nx) {
    const unsigned G = gridDim.x * gridDim.y * gridDim.z;
    unsigned sum, cnt, mine, sp = 0u;
    for (;;) {
        sum = 0u; cnt = 0u; mine = 0u;
#pragma unroll
        for (unsigned j = 0; j < 16; ++j) { const unsigned c = xb_ld(&bar[XB_XCNT(j)]); sum += c; cnt += (c > 0u) ? 1u : 0u; mine = (j == x) ? c : mine; }
        if (sum == G) break;
        __builtin_amdgcn_s_sleep(1);
        if ((++sp & 255u) == 0u) { if (xb_ld(&bar[XB_TMO])) break; if (sp > XB_SPIN_CAP) { atomicAdd(&bar[XB_TMO], 1u); break; } }
    }
    nloc = mine > 0u ? mine : 1u; nx = cnt > 0u ? cnt : 1u;
}

__device__ __forceinline__ void xcd_barrier(const XcdBarrier& b) {
    asm volatile("s_waitcnt vmcnt(0)" ::: "memory");
    __syncthreads();
    if (threadIdx.x == 0) {
        unsigned* bar = b.bar;
        __builtin_amdgcn_s_waitcnt(0);
        unsigned nloc = b.st[0], nx = b.st[1];
        if (nloc == 0u) { xcd_barrier_complete(bar, b.x, nloc, nx); b.st[0] = nloc; b.st[1] = nx; }
        const unsigned old = xb_add(&bar[XB_XSUB(b.x)], 1u);
        const unsigned gen = old / nloc;
        if (old + 1u == (gen + 1u) * nloc) {
            __builtin_amdgcn_fence(__ATOMIC_RELEASE, "agent");
            asm volatile("s_waitcnt vmcnt(0)" ::: "memory");
            const unsigned og = xb_add(&bar[XB_TOP], 1u);
            const unsigned tg = og / nx;
            if (og + 1u == (tg + 1u) * nx) xb_add(&bar[XB_TOPGEN], 1u);
            else XB_SPIN(xb_ld(&bar[XB_TOPGEN]) == tg, bar);
            __builtin_amdgcn_fence(__ATOMIC_ACQUIRE, "agent");
            xb_add(&bar[XB_XGEN(b.x)], 1u);
            asm volatile("s_waitcnt vmcnt(0)" ::: "memory");
        } else {
            XB_SPIN(xb_ld(&bar[XB_XGEN(b.x)]) == gen, bar);
            __builtin_amdgcn_fence(__ATOMIC_ACQUIRE, "agent");
            asm volatile("s_waitcnt vmcnt(0)" ::: "memory");
        }
    }
    __syncthreads();
}

constexpr int NWAVES = 8;
constexpr int DM = 1024, NB = 4, SEQ = 4096, MP = NB * SEQ, DB = 128, DT = 4, MS = DB * DT, MA = MP + MS;
constexpr int NIN = 2560, NUP = 5632, DFF = 2816, NADA = 6144, PAST = 2048;
constexpr float EPS = 1e-6f, LAM0 = 0.2f;
constexpr float C2 = attn_body::C2;
static_assert(MP == pg8::MPROMPT, "row split");
constexpr size_t O_YP = 0, O_YS = 16777216, O_KP = 17301504, O_VP = 25690112, O_LCP = 34078720, O_LHP = 34084864, O_FCP = 34086912,
                 O_KS = 34131968, O_VS = 34394112, O_LCS = 34656256, O_LHS = 34852864, O_FCS = 34918400, O_END = 36360192;
constexpr size_t MiB = 1u << 20;
constexpr size_t WS_CTL = 0, CTL_ZERO_BYTES = 1 * MiB;
constexpr size_t WS_WADA = 2 * MiB, WS_WIN = 14 * MiB, WS_WOUT = 19 * MiB, WS_WUP = 21 * MiB, WS_WDN = 32 * MiB;
constexpr size_t WS_SC = 38 * MiB, WS_MOD = 39 * MiB, WS_ROPE = 45 * MiB, WS_SEGA = 46 * MiB, WS_SEGB = 46 * MiB + 512 * 1024;
constexpr size_t WS_XN = 48 * MiB, WS_PROJ = 81 * MiB, WS_QB = 164 * MiB, WS_KB = 181 * MiB, WS_OB = 198 * MiB, WS_HL = 230 * MiB, WS_CA = 247 * MiB;
constexpr size_t WS_MIX = 264 * MiB, WS_X1 = 297 * MiB, WS_UP = 363 * MiB, WS_ACT = 545 * MiB, WS_END = 636 * MiB;
constexpr int CW_BAR = 4096;

constexpr int RING_OFF = 0, RING_BYTES = 131072, EXTRA_BYTES = 1024;
constexpr int LDSCTL_OFF = RING_BYTES + EXTRA_BYTES, MISC_OFF = LDSCTL_OFF + 320;
constexpr int LDS_BYTES = 147456;
static_assert(MISC_OFF + 128 <= LDS_BYTES, "LDS map");

typedef unsigned u32x2v __attribute__((ext_vector_type(2)));
typedef float f32x2v __attribute__((ext_vector_type(2)));

typedef const unsigned long long __attribute__((address_space(4)))* KIN;
struct Frame {
    LAS unsigned char* lds;
    volatile LAS unsigned* MISC;
    gu32* ctl;
    int tid, lane, wave, vcu, G;
    KIN kin; unsigned char* ws; float* out;
    __device__ __forceinline__ const float* inp(int k) const { return (const float*)(const GAS float*)kin[k]; }
};

__device__ __forceinline__ float wave_sum(float v) {
#pragma unroll
    for (int o = 1; o < 64; o <<= 1) v += __shfl_xor(v, o);
    return v;
}
__device__ __forceinline__ float bflo(unsigned w) { return __uint_as_float(w << 16); }
__device__ __forceinline__ float bfhi(unsigned w) { return __uint_as_float(w & 0xffff0000u); }
__device__ __forceinline__ void unpack8(const v4u r, float (&f)[8]) {
    f[0] = bflo(r.x); f[1] = bfhi(r.x); f[2] = bflo(r.y); f[3] = bfhi(r.y); f[4] = bflo(r.z); f[5] = bfhi(r.z); f[6] = bflo(r.w); f[7] = bfhi(r.w);
}
__device__ __forceinline__ v4u pack8(const float (&f)[8]) {
    v4u o; o.x = pg8::cvt_pk_bf16(f[0], f[1]); o.y = pg8::cvt_pk_bf16(f[2], f[3]); o.z = pg8::cvt_pk_bf16(f[4], f[5]); o.w = pg8::cvt_pk_bf16(f[6], f[7]); return o;
}
__device__ __forceinline__ float sigmoidf_(float x) { return 1.0f / (1.0f + __expf(-x)); }
__device__ __forceinline__ float gelu_tanh(float x) {
    const float u = 0.7978845608028654f * (x + 0.044715f * x * x * x);
    const float t = 1.0f - 2.0f / (1.0f + __expf(2.0f * u));
    return 0.5f * x * (1.0f + t);
}
__device__ __forceinline__ int mod_row(int m) { return (m < MP) ? (m >> 12) : 4 + ((m - MP) >> 2); }

__device__ __forceinline__ void p0_transpose_item(const float* W, int K, int N, bf16* WT, int row_off, LAS float* scr, int item, int lane) {
    const int nblk = N / 32, kb = item / nblk, nb = item % nblk, k0 = 64 * kb, n0 = 32 * nb;
#pragma unroll 8
    for (int i = 0; i < 32; ++i) { const int kk = 2 * i + (lane >> 5); scr[kk * 33 + (lane & 31)] = W[(size_t)(k0 + kk) * N + n0 + (lane & 31)]; }
    LDS_WAIT(); asm volatile("" ::: "memory");
    const int c = lane & 7;
#pragma unroll
    for (int j = 0; j < 4; ++j) { const int n = (lane >> 3) + 8 * j; const LAS float* s = scr + (8 * c) * 33 + n;
        v4u o; o.x = pk2(s[0 * 33], s[1 * 33]); o.y = pk2(s[2 * 33], s[3 * 33]); o.z = pk2(s[4 * 33], s[5 * 33]); o.w = pk2(s[6 * 33], s[7 * 33]);
        *(GAS v4u*)(WT + (size_t)(row_off + n0 + n) * K + k0 + 8 * c) = o; }
    LDS_WAIT(); asm volatile("" ::: "memory");
}
__device__ __forceinline__ void p0_prologue(Frame& F) {
    LAS float* scr = (LAS float*)(F.lds + RING_OFF + F.wave * 16384);
    const int gw = F.vcu * NWAVES + F.wave, NGW = F.G * NWAVES;
    constexpr int I_ADA = (DM / 64) * (NADA / 32), I_IN = (DM / 64) * (NIN / 32), I_OUT = (DM / 64) * (DM / 32), I_UP = (DM / 64) * (NUP / 32), I_DN = (DFF / 64) * (DM / 32);
    constexpr int NITEMS = I_ADA + I_IN + I_OUT + I_UP + I_DN;
    for (int it = gw; it < NITEMS; it += NGW) {
        int r = it;
        if (r < I_ADA) { p0_transpose_item(F.inp(12), DM, NADA, ((bf16*)(F.ws + WS_WADA)), 0, scr, r, F.lane); continue; } r -= I_ADA;
        if (r < I_IN) { p0_transpose_item(F.inp(14), DM, NIN, ((bf16*)(F.ws + WS_WIN)), 0, scr, r, F.lane); continue; } r -= I_IN;
        if (r < I_OUT) { p0_transpose_item(F.inp(22), DM, DM, ((bf16*)(F.ws + WS_WOUT)), 0, scr, r, F.lane); continue; } r -= I_OUT;
        if (r < I_UP) { p0_transpose_item(F.inp(30), DM, NUP, ((bf16*)(F.ws + WS_WUP)), 0, scr, r, F.lane); continue; } r -= I_UP;
        p0_transpose_item(F.inp(33), DFF, DM, ((bf16*)(F.ws + WS_WDN)), 0, scr, r, F.lane);
    }
    for (int r = gw; r < 256; r += NGW) {
        const float* src = (r < 4) ? F.inp(8) + (size_t)r * DM : F.inp(9) + (size_t)(r < 132 ? r - 4 : 0) * DM;
#pragma unroll
        for (int j = 0; j < 4; ++j) { const int c = 4 * F.lane + 256 * j; f32x4 v = *(const f32x4*)(src + c);
            if (r >= 132) v = (f32x4){0.f, 0.f, 0.f, 0.f};
            f32x4 s; s.x = v.x / (1.0f + __expf(-v.x)); s.y = v.y / (1.0f + __expf(-v.y)); s.z = v.z / (1.0f + __expf(-v.z)); s.w = v.w / (1.0f + __expf(-v.w));
            u32x2v o; o.x = pk2(s.x, s.y); o.y = pk2(s.z, s.w); *(u32x2v*)(((bf16*)(F.ws + WS_SC)) + (size_t)r * DM + c) = o; }
    }
    for (int e = gw * 64 + F.lane; e < SEQ * 8; e += NGW * 64) {
        const int pos = e >> 3, j = e & 7;
        const float freq = powf(500000.0f, -(float)j * 0.125f);
        const float ang = (float)pos * freq;
        ((float*)(F.ws + WS_ROPE))[2 * e] = cosf(ang); ((float*)(F.ws + WS_ROPE))[2 * e + 1] = sinf(ang);
    }
}

__device__ __forceinline__ void norm_mod_rows(Frame& F, const float* bp, const float* bs, const float* gn, int sc_off, int sh_off) {
    const int gw = F.vcu * NWAVES + F.wave, NGW = F.G * NWAVES;
    for (int m = gw; m < MA; m += NGW) {
        const float* xr = (m < MP) ? bp + (size_t)m * DM : bs + (size_t)(m - MP) * DM;
        const float* md = ((float*)(F.ws + WS_MOD)) + (size_t)mod_row(m) * NADA;
        f32x4 v[4]; float ss = 0.f;
#pragma unroll
        for (int j = 0; j < 4; ++j) { v[j] = *(const f32x4*)(xr + 4 * F.lane + 256 * j); ss += (v[j].x * v[j].x + v[j].y * v[j].y) + (v[j].z * v[j].z + v[j].w * v[j].w); }
        const float rstd = rsqrtf(wave_sum(ss) * (1.0f / DM) + EPS);
#pragma unroll
        for (int j = 0; j < 4; ++j) { const int c = 4 * F.lane + 256 * j;
            const f32x4 g = *(const f32x4*)(gn + c), sc = *(const f32x4*)(md + sc_off + c), sh = *(const f32x4*)(md + sh_off + c);
            const f32x4 o = v[j] * rstd * g * (sc + 1.0f) + sh;
            u32x2v w; w.x = pg8::cvt_pk_bf16(o.x, o.y); w.y = pg8::cvt_pk_bf16(o.z, o.w); *(u32x2v*)(((bf16*)(F.ws + WS_XN)) + (size_t)m * DM + c) = w; }
    }
}

__device__ __forceinline__ void p4_tile(Frame& F, int tile, const bf16x8 (&Bf)[2][2][4], const float (&brg)[4], const float (&big)[4], const float (&spl)[4]) {
    const int lane = F.lane, w = F.wave;
    const int m0 = tile * 64;
    const bool samp = (m0 >= MP);
    {
        const int d0 = (8 * lane) & 63, l8 = lane & 7;
        float gq[8], gk[8];
        { const f32x4 a = *(const f32x4*)(F.inp(15) + d0), b = *(const f32x4*)(F.inp(15) + d0 + 4), c = *(const f32x4*)(F.inp(16) + d0), d = *(const f32x4*)(F.inp(16) + d0 + 4);
          gq[0] = a.x; gq[1] = a.y; gq[2] = a.z; gq[3] = a.w; gq[4] = b.x; gq[5] = b.y; gq[6] = b.z; gq[7] = b.w;
          gk[0] = c.x; gk[1] = c.y; gk[2] = c.z; gk[3] = c.w; gk[4] = d.x; gk[5] = d.y; gk[6] = d.z; gk[7] = d.w; }
        for (int rr = 0; rr < 8; ++rr) {
            const int m = m0 + w * 8 + rr;
            const int tt = samp ? ((m - MP) & 3) : (m & (SEQ - 1));
            const int pos = samp ? PAST + tt : tt;
            const bf16* prow = ((bf16*)(F.ws + WS_PROJ)) + (size_t)m * NIN;
            const v4u qraw = *(const v4u*)(prow + 8 * lane), kraw = *(const v4u*)(prow + 512 + 8 * lane), vraw = *(const v4u*)(prow + 1024 + 8 * lane);
            float q[8], k[8], v[8]; unpack8(qraw, q); unpack8(kraw, k); unpack8(vraw, v);
            float sq = 0.f, sk = 0.f;
#pragma unroll
            for (int j = 0; j < 8; ++j) { sq += q[j] * q[j]; sk += k[j] * k[j]; }
            sq += __shfl_xor(sq, 1); sk += __shfl_xor(sk, 1); sq += __shfl_xor(sq, 2); sk += __shfl_xor(sk, 2); sq += __shfl_xor(sq, 4); sk += __shfl_xor(sk, 4);
            const float rq = rsqrtf(sq * (1.0f / 64.0f) + EPS), rk = rsqrtf(sk * (1.0f / 64.0f) + EPS);
#pragma unroll
            for (int j = 0; j < 8; ++j) { q[j] *= rq * gq[j]; k[j] *= rk * gk[j]; }
            const float* rp = ((float*)(F.ws + WS_ROPE)) + (size_t)pos * 16;
            const f32x4 t0 = *(const f32x4*)(rp), t1 = *(const f32x4*)(rp + 4), t2 = *(const f32x4*)(rp + 8), t3 = *(const f32x4*)(rp + 12);
            const float cs[8] = {t0.x, t0.z, t1.x, t1.z, t2.x, t2.z, t3.x, t3.z}, sn[8] = {t0.y, t0.w, t1.y, t1.w, t2.y, t2.w, t3.y, t3.w};
#pragma unroll
            for (int j = 0; j < 8; ++j) { const float pq = __shfl_xor(q[j], 1), pk = __shfl_xor(k[j], 1);
                if (l8 == 0) { q[j] = q[j] * cs[j] - pq * sn[j]; k[j] = k[j] * cs[j] - pk * sn[j]; }
                else if (l8 == 1) { q[j] = pq * sn[j] + q[j] * cs[j]; k[j] = pk * sn[j] + k[j] * cs[j]; } }
            float* kout = samp ? F.out + O_KS + (size_t)(m - MP) * 512 + 8 * lane : F.out + O_KP + (size_t)m * 512 + 8 * lane;
            float* vout = samp ? F.out + O_VS + (size_t)(m - MP) * 512 + 8 * lane : F.out + O_VP + (size_t)m * 512 + 8 * lane;
            *(f32x4*)kout = (f32x4){k[0], k[1], k[2], k[3]}; *(f32x4*)(kout + 4) = (f32x4){k[4], k[5], k[6], k[7]};
            *(f32x4*)vout = (f32x4){v[0], v[1], v[2], v[3]}; *(f32x4*)(vout + 4) = (f32x4){v[4], v[5], v[6], v[7]};
            *(v4u*)(((bf16*)(F.ws + WS_KB)) + (size_t)m * 512 + 8 * lane) = pack8(k);
#pragma unroll
            for (int j = 0; j < 8; ++j) q[j] *= C2;
            *(v4u*)(((bf16*)(F.ws + WS_QB)) + (size_t)m * 512 + 8 * lane) = pack8(q);
            const int kk = samp ? tt - 1 : tt - (SEQ - 3);
            if (kk >= 0) {
                const v4u lraw = *(const v4u*)(prow + 1536 + 8 * lane); float lx[8]; unpack8(lraw, lx);
                float* lo = samp ? F.out + O_LCS + ((size_t)((m - MP) >> 2) * 3 + kk) * 512 + 8 * lane : F.out + O_LCP + ((size_t)(m >> 12) * 3 + kk) * 512 + 8 * lane;
                *(f32x4*)lo = (f32x4){lx[0], lx[1], lx[2], lx[3]}; *(f32x4*)(lo + 4) = (f32x4){lx[4], lx[5], lx[6], lx[7]};
            }
        }
    }
    {
        LAS float* XC = (LAS float*)(F.lds + RING_OFF + w * 8704);
        LAS float* LA = XC + 16 * 68;
        const int ch0 = w * 64, c8 = lane & 7, tr = lane >> 3, fr = lane & 15, fq = lane >> 4;
        float cw[4][8], cb[8];
#pragma unroll
        for (int k = 0; k < 4; ++k) { const f32x4 a = *(const f32x4*)(F.inp(23) + k * 512 + ch0 + 8 * c8), b = *(const f32x4*)(F.inp(23) + k * 512 + ch0 + 8 * c8 + 4);
            cw[k][0] = a.x; cw[k][1] = a.y; cw[k][2] = a.z; cw[k][3] = a.w; cw[k][4] = b.x; cw[k][5] = b.y; cw[k][6] = b.z; cw[k][7] = b.w; }
        { const f32x4 a = *(const f32x4*)(F.inp(24) + ch0 + 8 * c8), b = *(const f32x4*)(F.inp(24) + ch0 + 8 * c8 + 4);
          cb[0] = a.x; cb[1] = a.y; cb[2] = a.z; cb[3] = a.w; cb[4] = b.x; cb[5] = b.y; cb[6] = b.z; cb[7] = b.w; }
        float hA = 1.0f, hB = 0.0f;
        for (int sub = 0; sub < 4; ++sub) {
            const int mt = m0 + 16 * sub;
#pragma unroll
            for (int i = 0; i < 2; ++i) {
                const int tok = tr + 8 * i, m = mt + tok;
                const int tt = samp ? ((m - MP) & 3) : (m & (SEQ - 1));
                float acc[8];
#pragma unroll
                for (int j = 0; j < 8; ++j) acc[j] = cb[j];
#pragma unroll
                for (int kk = 0; kk < 4; ++kk) {
                    float lx[8];
                    if (tt - kk >= 0) { const v4u r = *(const v4u*)(((bf16*)(F.ws + WS_PROJ)) + (size_t)(m - kk) * NIN + 1536 + ch0 + 8 * c8); unpack8(r, lx); }
                    else if (samp) { const float* sp = F.inp(5) + ((size_t)((m - MP) >> 2) * 3 + (tt - kk + 3)) * 512 + ch0 + 8 * c8;
                        const f32x4 a = *(const f32x4*)sp, b = *(const f32x4*)(sp + 4); lx[0] = a.x; lx[1] = a.y; lx[2] = a.z; lx[3] = a.w; lx[4] = b.x; lx[5] = b.y; lx[6] = b.z; lx[7] = b.w; }
                    else {
#pragma unroll
                        for (int j = 0; j < 8; ++j) lx[j] = 0.f; }
#pragma unroll
                    for (int j = 0; j < 8; ++j) acc[j] += cw[3 - kk][j] * lx[j];
                }
                *(LAS f32x4*)(XC + tok * 68 + 8 * c8) = (f32x4){acc[0], acc[1], acc[2], acc[3]};
                *(LAS f32x4*)(XC + tok * 68 + 8 * c8 + 4) = (f32x4){acc[4], acc[5], acc[6], acc[7]};
            }
            LDS_WAIT(); asm volatile("" ::: "memory");
            f32x4 Dr[4], Di[4];
#pragma unroll
            for (int ct = 0; ct < 4; ++ct) { Dr[ct] = (f32x4){0.f, 0.f, 0.f, 0.f}; Di[ct] = (f32x4){0.f, 0.f, 0.f, 0.f}; }
#pragma unroll
            for (int s = 0; s < 2; ++s) {
                const LAS float* ap = XC + fr * 68 + 32 * s + 8 * fq;
                const f32x4 a0 = *(const LAS f32x4*)ap, a1 = *(const LAS f32x4*)(ap + 4);
                v4u aw; aw.x = pg8::cvt_pk_bf16(a0.x, a0.y); aw.y = pg8::cvt_pk_bf16(a0.z, a0.w); aw.z = pg8::cvt_pk_bf16(a1.x, a1.y); aw.w = pg8::cvt_pk_bf16(a1.z, a1.w);
                const bf16x8 af = __builtin_bit_cast(bf16x8, aw);
#pragma unroll
                for (int ct = 0; ct < 4; ++ct) { Dr[ct] = __builtin_amdgcn_mfma_f32_16x16x32_bf16(af, Bf[0][s][ct], Dr[ct], 0, 0, 0); Di[ct] = __builtin_amdgcn_mfma_f32_16x16x32_bf16(af, Bf[1][s][ct], Di[ct], 0, 0, 0); }
            }
#pragma unroll
            for (int ct = 0; ct < 4; ++ct)
#pragma unroll
                for (int i = 0; i < 4; ++i) { const int o = (4 * fq + i) * 68 + 16 * ct + fr;
                    const float xcv = XC[o], r = sigmoidf_(Dr[ct][i] + brg[ct]), ig = sigmoidf_(Di[ct][i] + big[ct]);
                    const float la = -8.0f * r * spl[ct], a = __expf(la), x2 = 2.0f * la;
                    const float em = (x2 > -0.1f) ? x2 * (1.0f + x2 * (0.5f + x2 * (0.16666667f + x2 * 0.041666668f))) : __expf(x2) - 1.0f;
                    LA[o] = a; XC[o] = sqrtf(-em) * ig * xcv; }
            LDS_WAIT(); asm volatile("" ::: "memory");
#pragma unroll
            for (int tok = 0; tok < 16; ++tok) {
                if (samp && (tok & 3) == 0) { hB = F.inp(6)[(size_t)((mt + tok - MP) >> 2) * 512 + ch0 + lane]; hA = 1.0f; }
                const float a = LA[tok * 68 + lane], bb = XC[tok * 68 + lane];
                hB = a * hB + bb; hA *= a; XC[tok * 68 + lane] = hB; LA[tok * 68 + lane] = hA;
            }
            LDS_WAIT(); asm volatile("" ::: "memory");
#pragma unroll
            for (int i = 0; i < 2; ++i) { const int tok = tr + 8 * i; const size_t go = (size_t)(mt + tok) * 512 + ch0 + 8 * c8;
                const f32x4 h0 = *(const LAS f32x4*)(XC + tok * 68 + 8 * c8), h1 = *(const LAS f32x4*)(XC + tok * 68 + 8 * c8 + 4);
                const f32x4 a0 = *(const LAS f32x4*)(LA + tok * 68 + 8 * c8), a1 = *(const LAS f32x4*)(LA + tok * 68 + 8 * c8 + 4);
                v4u hw, awv; hw.x = pg8::cvt_pk_bf16(h0.x, h0.y); hw.y = pg8::cvt_pk_bf16(h0.z, h0.w); hw.z = pg8::cvt_pk_bf16(h1.x, h1.y); hw.w = pg8::cvt_pk_bf16(h1.z, h1.w);
                awv.x = pg8::cvt_pk_bf16(a0.x, a0.y); awv.y = pg8::cvt_pk_bf16(a0.z, a0.w); awv.z = pg8::cvt_pk_bf16(a1.x, a1.y); awv.w = pg8::cvt_pk_bf16(a1.z, a1.w);
                *(v4u*)(((bf16*)(F.ws + WS_HL)) + go) = hw; *(v4u*)(((bf16*)(F.ws + WS_CA)) + go) = awv; }
            LDS_WAIT(); asm volatile("" ::: "memory");
        }
        if (!samp) { const size_t so = ((size_t)(m0 >> 12) * 64 + ((m0 & (SEQ - 1)) >> 6)) * 512 + ch0 + lane; ((float*)(F.ws + WS_SEGA))[so] = hA; ((float*)(F.ws + WS_SEGB))[so] = hB; }
    }
}
__device__ __forceinline__ void p4_phase(Frame& F) {
    const int lane = F.lane, w = F.wave, fr = lane & 15, fq = lane >> 4;
    bf16x8 Bf[2][2][4];
#pragma unroll
    for (int gt = 0; gt < 2; ++gt) { const float* W = (gt == 0 ? F.inp(25) : F.inp(27)) + (size_t)w * 4096;
#pragma unroll
        for (int s = 0; s < 2; ++s)
#pragma unroll
            for (int ct = 0; ct < 4; ++ct) { float e[8];
#pragma unroll
                for (int j = 0; j < 8; ++j) e[j] = W[(32 * s + 8 * fq + j) * 64 + 16 * ct + fr];
                Bf[gt][s][ct] = __builtin_bit_cast(bf16x8, pack8(e)); } }
    float brg[4], big[4], spl[4];
#pragma unroll
    for (int ct = 0; ct < 4; ++ct) { const int ch = w * 64 + 16 * ct + fr; brg[ct] = F.inp(26)[ch]; big[ct] = F.inp(28)[ch]; spl[ct] = log1pf(__expf(-F.inp(29)[ch])); }
    for (int tile = F.vcu; tile < MA / 64; tile += F.G) p4_tile(F, tile, Bf, brg, big, spl);
}

template <int CTRL> __device__ __forceinline__ float dppf(float x) { return __builtin_bit_cast(float, __builtin_amdgcn_mov_dpp(__builtin_bit_cast(int, x), CTRL, 0xf, 0xf, true)); }
constexpr int DPP_XOR1 = 0xB1, DPP_XOR2 = 0x4E, DPP_XOR7 = 0x141, DPP_ROR8 = 0x128, DPP_ROR4 = 0x124;
__device__ __forceinline__ float sa_group(const f32x4& k0, const f32x4& k1, const f32x4& k2, const f32x4& k3, const float (&q)[4][4], int l16) {
    float v[16];
#pragma unroll
    for (int qi = 0; qi < 4; ++qi) {
        v[0 + qi] = k0.x * q[qi][0] + k0.y * q[qi][1] + k0.z * q[qi][2] + k0.w * q[qi][3];
        v[4 + qi] = k1.x * q[qi][0] + k1.y * q[qi][1] + k1.z * q[qi][2] + k1.w * q[qi][3];
        v[8 + qi] = k2.x * q[qi][0] + k2.y * q[qi][1] + k2.z * q[qi][2] + k2.w * q[qi][3];
        v[12 + qi] = k3.x * q[qi][0] + k3.y * q[qi][1] + k3.z * q[qi][2] + k3.w * q[qi][3];
    }
    const bool b3 = (l16 & 8) != 0, b2 = (l16 & 4) != 0, b1 = (l16 & 2) != 0, b0 = (l16 & 1) != 0;
#pragma unroll
    for (int a = 0; a < 8; ++a) { const float keep = b3 ? v[a + 8] : v[a], send = b3 ? v[a] : v[a + 8]; v[a] = keep + dppf<DPP_ROR8>(send); }
#pragma unroll
    for (int a = 0; a < 4; ++a) { const float keep = b2 ? v[a + 4] : v[a], send = b2 ? v[a] : v[a + 4]; v[a] = keep + dppf<DPP_XOR7>(send); }
#pragma unroll
    for (int a = 0; a < 2; ++a) { const float keep = b1 ? v[a + 2] : v[a], send = b1 ? v[a] : v[a + 2]; v[a] = keep + dppf<DPP_XOR2>(send); }
    const float keep = b0 ? v[1] : v[0], send = b0 ? v[0] : v[1];
    return keep + dppf<DPP_XOR1>(send);
}
__device__ __forceinline__ f32x4 ntload4(const float* p) { return __builtin_nontemporal_load((const f32x4*)p); }
__device__ __forceinline__ void sattn_unit(Frame& F, int s, int hp, float lam) {
    const int lane = F.lane, w = F.wave, l16 = lane & 15, grp = lane >> 4;
    LAS float* SB = (LAS float*)(F.lds + RING_OFF) + w * 4096;
    const int mrow0 = MP + s * 4;
    const int qcol = (2 * hp + (grp >> 1)) * 128 + (grp & 1) * 64 + 4 * l16;
    float q[4][4];
#pragma unroll
    for (int qi = 0; qi < 4; ++qi) { const u32x2v r = *(const u32x2v*)(((bf16*)(F.ws + WS_QB)) + (size_t)(mrow0 + qi) * 512 + qcol); q[qi][0] = bflo(r.x); q[qi][1] = bfhi(r.x); q[qi][2] = bflo(r.y); q[qi][3] = bfhi(r.y); }
    const int pg0 = __builtin_amdgcn_readfirstlane(((const int*)(const GAS int*)F.kin[4])[s * 16 + 2 * w]), pg1 = __builtin_amdgcn_readfirstlane(((const int*)(const GAS int*)F.kin[4])[s * 16 + 2 * w + 1]);
    const int ridx = (l16 >> 2) * 16 + grp * 4 + (l16 & 3);
    float mx = -INFINITY;
    {
        const float* kb0 = F.inp(2) + ((size_t)pg0 * 512 + 2 * hp) * 128 + 4 * lane;
        const float* kb1 = F.inp(2) + ((size_t)pg1 * 512 + 2 * hp) * 128 + 4 * lane;
        f32x4 cur[8], nxt[8];
#pragma unroll
        for (int i = 0; i < 8; ++i) cur[i] = ntload4(kb0 + (size_t)i * 512);
        for (int g2 = 0; g2 < 32; ++g2) {
            if (g2 + 1 < 32) { const int j0 = 8 * (g2 + 1); const float* kb = (j0 < 128) ? kb0 + (size_t)j0 * 512 : kb1 + (size_t)(j0 - 128) * 512;
#pragma unroll
                for (int i = 0; i < 8; ++i) nxt[i] = ntload4(kb + (size_t)i * 512); }
            const float s0 = sa_group(cur[0], cur[1], cur[2], cur[3], q, l16), s1 = sa_group(cur[4], cur[5], cur[6], cur[7], q, l16);
            SB[(2 * g2) * 64 + ridx] = s0; SB[(2 * g2 + 1) * 64 + ridx] = s1; mx = fmaxf(mx, fmaxf(s0, s1));
#pragma unroll
            for (int i = 0; i < 8; ++i) cur[i] = nxt[i];
        }
    }
    int NG = 64;
    if (w == 7) {
        f32x4 kn[4];
#pragma unroll
        for (int g = 0; g < 4; ++g) { const u32x2v r = *(const u32x2v*)(((bf16*)(F.ws + WS_KB)) + (size_t)(mrow0 + g) * 512 + qcol); kn[g] = (f32x4){bflo(r.x), bfhi(r.x), bflo(r.y), bfhi(r.y)}; }
        float sc = sa_group(kn[0], kn[1], kn[2], kn[3], q, l16);
        if ((l16 >> 2) > (l16 & 3)) sc = -INFINITY;
        SB[64 * 64 + ridx] = sc; mx = fmaxf(mx, sc); NG = 65;
    }
    mx = fmaxf(mx, dppf<DPP_ROR4>(mx)); mx = fmaxf(mx, dppf<DPP_ROR8>(mx));
    LDS_WAIT(); asm volatile("" ::: "memory");
    float ls = 0.f;
    for (int g = 0; g < NG; ++g) { const float p = __builtin_amdgcn_exp2f(SB[g * 64 + ridx] - mx); ls += p; SB[g * 64 + ridx] = p; }
    ls += dppf<DPP_ROR4>(ls); ls += dppf<DPP_ROR8>(ls);
    LDS_WAIT(); asm volatile("" ::: "memory");
    const int hh = lane >> 5, dv4 = 4 * (lane & 31);
    f32x4 O[8];
#pragma unroll
    for (int r = 0; r < 8; ++r) O[r] = (f32x4){0.f, 0.f, 0.f, 0.f};
    {
        const float* vb0 = F.inp(3) + ((size_t)pg0 * 512 + 2 * hp + hh) * 128 + dv4;
        const float* vb1 = F.inp(3) + ((size_t)pg1 * 512 + 2 * hp + hh) * 128 + dv4;
        f32x4 cur[8], nxt[8];
#pragma unroll
        for (int i = 0; i < 8; ++i) cur[i] = ntload4(vb0 + (size_t)i * 512);
        for (int g2 = 0; g2 < 32; ++g2) {
            if (g2 + 1 < 32) { const int j0 = 8 * (g2 + 1); const float* vb = (j0 < 128) ? vb0 + (size_t)j0 * 512 : vb1 + (size_t)(j0 - 128) * 512;
#pragma unroll
                for (int i = 0; i < 8; ++i) nxt[i] = ntload4(vb + (size_t)i * 512); }
#pragma unroll
            for (int i = 0; i < 8; ++i) { const LAS f32x4* pp = (const LAS f32x4*)(SB + (8 * g2 + i) * 16 + hh * 8); const f32x4 p0 = pp[0], p1 = pp[1];
#pragma unroll
                for (int r = 0; r < 4; ++r) { O[r] += cur[i] * p0[r]; O[4 + r] += cur[i] * p1[r]; } }
#pragma unroll
            for (int i = 0; i < 8; ++i) cur[i] = nxt[i];
        }
        if (w == 7) {
#pragma unroll
            for (int g = 0; g < 4; ++g) { const u32x2v r = *(const u32x2v*)(((bf16*)(F.ws + WS_PROJ)) + (size_t)(mrow0 + g) * NIN + 1024 + (2 * hp + hh) * 128 + dv4);
                const f32x4 vv = (f32x4){bflo(r.x), bfhi(r.x), bflo(r.y), bfhi(r.y)};
                const LAS f32x4* pp = (const LAS f32x4*)(SB + (256 + g) * 16 + hh * 8); const f32x4 p0 = pp[0], p1 = pp[1];
#pragma unroll
                for (int rr = 0; rr < 4; ++rr) { O[rr] += vv * p0[rr]; O[4 + rr] += vv * p1[rr]; } }
        }
    }
    LDS_WAIT(); __syncthreads();
    LAS float* OW = (LAS float*)(F.lds + RING_OFF);
    LAS float* ML = OW + 8 * 16 * 128;
#pragma unroll
    for (int r = 0; r < 8; ++r) *(LAS f32x4*)(OW + (size_t)((w * 16 + hh * 8 + r) * 128) + dv4) = O[r];
    if (l16 < 4) { const int row16 = grp * 4 + l16; ML[(w * 16 + row16) * 2] = mx; ML[(w * 16 + row16) * 2 + 1] = ls; }
    LDS_WAIT(); __syncthreads();
    {
        const int hh2 = w >> 2, qi = w & 3; float oc[2][2];
#pragma unroll
        for (int c = 0; c < 2; ++c) { const int row16 = hh2 * 8 + c * 4 + qi; float M = -INFINITY;
#pragma unroll
            for (int ww = 0; ww < 8; ++ww) M = fmaxf(M, ML[(ww * 16 + row16) * 2]);
            float L = 0.f, a0 = 0.f, a1 = 0.f;
#pragma unroll
            for (int ww = 0; ww < 8; ++ww) { const float f = __builtin_amdgcn_exp2f(ML[(ww * 16 + row16) * 2] - M); L += f * ML[(ww * 16 + row16) * 2 + 1];
                const f32x2v o = *(const LAS f32x2v*)(OW + (ww * 16 + row16) * 128 + 2 * lane); a0 += f * o.x; a1 += f * o.y; }
            const float inv = 1.0f / L; oc[c][0] = a0 * inv; oc[c][1] = a1 * inv; }
        const float o0 = oc[0][0] - lam * oc[1][0], o1 = oc[0][1] - lam * oc[1][1];
        const float rstd = rsqrtf(wave_sum(o0 * o0 + o1 * o1) * (1.0f / 128.0f) + EPS);
        const float g0 = F.inp(21)[2 * lane], g1 = F.inp(21)[2 * lane + 1];
        *(unsigned*)(((bf16*)(F.ws + WS_MIX)) + (size_t)(mrow0 + qi) * DM + (2 * hp + hh2) * 128 + 2 * lane) = pg8::cvt_pk_bf16(o0 * rstd * g0 * (1.0f - LAM0), o1 * rstd * g1 * (1.0f - LAM0));
    }
    LDS_WAIT(); __syncthreads();
}
__device__ __forceinline__ float diff_lambda(Frame& F) {
    const float a = wave_sum(F.inp(17)[F.lane] * F.inp(18)[F.lane]), b = wave_sum(F.inp(19)[F.lane] * F.inp(20)[F.lane]);
    return __expf(a) - __expf(b) + LAM0;
}

__device__ __forceinline__ void p6_tile(Frame& F, int tile, float lam) {
    const int lane = F.lane, w = F.wave, m0 = tile * 64;
    const bool samp = (m0 >= MP);
    LAS float* CARRY = (LAS float*)(F.lds + RING_OFF);
    {
        float carry = 0.f;
        if (!samp) { const int b = m0 >> 12, seg = (m0 & (SEQ - 1)) >> 6; const float* pa = ((float*)(F.ws + WS_SEGA)) + (size_t)b * 64 * 512 + F.tid; const float* pb = ((float*)(F.ws + WS_SEGB)) + (size_t)b * 64 * 512 + F.tid;
            for (int sg = 0; sg < seg; ++sg) carry = pa[(size_t)sg * 512] * carry + pb[(size_t)sg * 512]; }
        CARRY[F.tid] = carry;
    }
    LDS_WAIT(); __syncthreads();
    float cr[8];
    { const f32x4 a = *(const LAS f32x4*)(CARRY + 8 * lane), b = *(const LAS f32x4*)(CARRY + 8 * lane + 4); cr[0] = a.x; cr[1] = a.y; cr[2] = a.z; cr[3] = a.w; cr[4] = b.x; cr[5] = b.y; cr[6] = b.z; cr[7] = b.w; }
    float gs[8];
    { const int dv = 8 * (lane & 15); const f32x4 a = *(const f32x4*)(F.inp(21) + dv), b = *(const f32x4*)(F.inp(21) + dv + 4); gs[0] = a.x; gs[1] = a.y; gs[2] = a.z; gs[3] = a.w; gs[4] = b.x; gs[5] = b.y; gs[6] = b.z; gs[7] = b.w; }
    for (int rr = 0; rr < 8; ++rr) {
        const int m = m0 + w * 8 + rr;
        if (!samp) {
            const bf16* orow = ((bf16*)(F.ws + WS_OB)) + (size_t)m * 1024 + (lane >> 4) * 256 + 8 * (lane & 15);
            const v4u r0 = *(const v4u*)orow, r1 = *(const v4u*)(orow + 128);
            float o0[8], o1[8]; unpack8(r0, o0); unpack8(r1, o1);
            float ss = 0.f;
#pragma unroll
            for (int j = 0; j < 8; ++j) { o0[j] -= lam * o1[j]; ss += o0[j] * o0[j]; }
            ss += __shfl_xor(ss, 1); ss += __shfl_xor(ss, 2); ss += __shfl_xor(ss, 4); ss += __shfl_xor(ss, 8);
            const float rstd = rsqrtf(ss * (1.0f / 128.0f) + EPS) * (1.0f - LAM0);
#pragma unroll
            for (int j = 0; j < 8; ++j) o0[j] *= rstd * gs[j];
            *(v4u*)(((bf16*)(F.ws + WS_MIX)) + (size_t)m * DM + 8 * lane) = pack8(o0);
        }
        {
            const v4u hr = *(const v4u*)(((bf16*)(F.ws + WS_HL)) + (size_t)m * 512 + 8 * lane), ar = *(const v4u*)(((bf16*)(F.ws + WS_CA)) + (size_t)m * 512 + 8 * lane), gr = *(const v4u*)(((bf16*)(F.ws + WS_PROJ)) + (size_t)m * NIN + 2048 + 8 * lane);
            float h[8], a[8], lg[8]; unpack8(hr, h); unpack8(ar, a); unpack8(gr, lg);
#pragma unroll
            for (int j = 0; j < 8; ++j) h[j] += a[j] * cr[j];
            const int tt = samp ? ((m - MP) & 3) : (m & (SEQ - 1));
            if (tt == (samp ? 3 : SEQ - 1)) { float* ho = samp ? F.out + O_LHS + (size_t)((m - MP) >> 2) * 512 + 8 * lane : F.out + O_LHP + (size_t)(m >> 12) * 512 + 8 * lane;
                *(f32x4*)ho = (f32x4){h[0], h[1], h[2], h[3]}; *(f32x4*)(ho + 4) = (f32x4){h[4], h[5], h[6], h[7]}; }
#pragma unroll
            for (int j = 0; j < 8; ++j) h[j] *= gelu_tanh(lg[j]);
            *(v4u*)(((bf16*)(F.ws + WS_MIX)) + (size_t)m * DM + 512 + 8 * lane) = pack8(h);
        }
    }
    LDS_WAIT(); __syncthreads();
}

__device__ __forceinline__ void p10_phase(Frame& F) {
    const int c = F.tid;
    const bool act = (c < DFF / 8);
    const int cg = act ? 8 * c : 0, cv = DFF + cg;
    float wg[3][8], wv[3][8], bg[8], bv[8];
#pragma unroll
    for (int k = 0; k < 3; ++k) { const f32x4 a = *(const f32x4*)(F.inp(31) + k * NUP + cg), b = *(const f32x4*)(F.inp(31) + k * NUP + cg + 4), d = *(const f32x4*)(F.inp(31) + k * NUP + cv), e = *(const f32x4*)(F.inp(31) + k * NUP + cv + 4);
        wg[k][0] = a.x; wg[k][1] = a.y; wg[k][2] = a.z; wg[k][3] = a.w; wg[k][4] = b.x; wg[k][5] = b.y; wg[k][6] = b.z; wg[k][7] = b.w;
        wv[k][0] = d.x; wv[k][1] = d.y; wv[k][2] = d.z; wv[k][3] = d.w; wv[k][4] = e.x; wv[k][5] = e.y; wv[k][6] = e.z; wv[k][7] = e.w; }
    { const f32x4 a = *(const f32x4*)(F.inp(32) + cg), b = *(const f32x4*)(F.inp(32) + cg + 4), d = *(const f32x4*)(F.inp(32) + cv), e = *(const f32x4*)(F.inp(32) + cv + 4);
      bg[0] = a.x; bg[1] = a.y; bg[2] = a.z; bg[3] = a.w; bg[4] = b.x; bg[5] = b.y; bg[6] = b.z; bg[7] = b.w;
      bv[0] = d.x; bv[1] = d.y; bv[2] = d.z; bv[3] = d.w; bv[4] = e.x; bv[5] = e.y; bv[6] = e.z; bv[7] = e.w; }
    if (!act) return;
    for (int tile = F.vcu; tile < MA / 16; tile += F.G) {
        const int m0 = tile * 16; const bool samp = (m0 >= MP);
        float g2[8], v2[8], g1[8], v1[8];
        if (!samp) {
            if ((m0 & (SEQ - 1)) == 0) {
#pragma unroll
                for (int j = 0; j < 8; ++j) { g2[j] = 0.f; v2[j] = 0.f; g1[j] = 0.f; v1[j] = 0.f; } }
            else { unpack8(*(const v4u*)(((bf16*)(F.ws + WS_UP)) + (size_t)(m0 - 2) * NUP + cg), g2); unpack8(*(const v4u*)(((bf16*)(F.ws + WS_UP)) + (size_t)(m0 - 2) * NUP + cv), v2);
                   unpack8(*(const v4u*)(((bf16*)(F.ws + WS_UP)) + (size_t)(m0 - 1) * NUP + cg), g1); unpack8(*(const v4u*)(((bf16*)(F.ws + WS_UP)) + (size_t)(m0 - 1) * NUP + cv), v1); }
        }
        for (int r = 0; r < 16; ++r) {
            const int m = m0 + r;
            if (samp && (r & 3) == 0) { const float* sp = F.inp(7) + (size_t)((m - MP) >> 2) * 2 * NUP;
                const f32x4 a = *(const f32x4*)(sp + cg), b = *(const f32x4*)(sp + cg + 4), d = *(const f32x4*)(sp + cv), e = *(const f32x4*)(sp + cv + 4);
                const f32x4 a1 = *(const f32x4*)(sp + NUP + cg), b1 = *(const f32x4*)(sp + NUP + cg + 4), d1 = *(const f32x4*)(sp + NUP + cv), e1 = *(const f32x4*)(sp + NUP + cv + 4);
                g2[0] = a.x; g2[1] = a.y; g2[2] = a.z; g2[3] = a.w; g2[4] = b.x; g2[5] = b.y; g2[6] = b.z; g2[7] = b.w;
                v2[0] = d.x; v2[1] = d.y; v2[2] = d.z; v2[3] = d.w; v2[4] = e.x; v2[5] = e.y; v2[6] = e.z; v2[7] = e.w;
                g1[0] = a1.x; g1[1] = a1.y; g1[2] = a1.z; g1[3] = a1.w; g1[4] = b1.x; g1[5] = b1.y; g1[6] = b1.z; g1[7] = b1.w;
                v1[0] = d1.x; v1[1] = d1.y; v1[2] = d1.z; v1[3] = d1.w; v1[4] = e1.x; v1[5] = e1.y; v1[6] = e1.z; v1[7] = e1.w; }
            float g0[8], v0[8]; unpack8(*(const v4u*)(((bf16*)(F.ws + WS_UP)) + (size_t)m * NUP + cg), g0); unpack8(*(const v4u*)(((bf16*)(F.ws + WS_UP)) + (size_t)m * NUP + cv), v0);
            float o[8];
#pragma unroll
            for (int j = 0; j < 8; ++j) { const float hg = bg[j] + wg[0][j] * g2[j] + wg[1][j] * g1[j] + wg[2][j] * g0[j], hv = bv[j] + wv[0][j] * v2[j] + wv[1][j] * v1[j] + wv[2][j] * v0[j];
                o[j] = hg / (1.0f + __expf(-hg)) * hv; }
            *(v4u*)(((bf16*)(F.ws + WS_ACT)) + (size_t)m * DFF + cg) = pack8(o);
            const int tt = samp ? ((m - MP) & 3) : (m & (SEQ - 1)); const int kk = samp ? tt - 2 : tt - (SEQ - 2);
            if (kk >= 0) { float* fo = samp ? F.out + O_FCS + ((size_t)((m - MP) >> 2) * 2 + kk) * NUP : F.out + O_FCP + ((size_t)(m >> 12) * 2 + kk) * NUP;
                *(f32x4*)(fo + cg) = (f32x4){g0[0], g0[1], g0[2], g0[3]}; *(f32x4*)(fo + cg + 4) = (f32x4){g0[4], g0[5], g0[6], g0[7]};
                *(f32x4*)(fo + cv) = (f32x4){v0[0], v0[1], v0[2], v0[3]}; *(f32x4*)(fo + cv + 4) = (f32x4){v0[4], v0[5], v0[6], v0[7]}; }
#pragma unroll
            for (int j = 0; j < 8; ++j) { g2[j] = g1[j]; v2[j] = v1[j]; g1[j] = g0[j]; v1[j] = v0[j]; }
        }
    }
}

struct Args { const void* in[34]; float* out; unsigned char* ws; int ph_lo, ph_hi; };
constexpr int N_PHASES = 12;
__global__ void __launch_bounds__(NWAVES * 64, 2) mk_fwd(Args args) {
    extern __shared__ __attribute__((aligned(16))) unsigned char lds[];
    Frame F;
    F.lds = (LAS unsigned char*)lds;
    F.MISC = (volatile LAS unsigned*)(F.lds + MISC_OFF);
    F.tid = threadIdx.x; F.lane = F.tid & 63; F.wave = __builtin_amdgcn_readfirstlane(F.tid >> 6);
    F.G = gridDim.x; { const int bx = blockIdx.x; F.vcu = (F.G % 8 == 0) ? (bx % 8) * (F.G / 8) + bx / 8 : bx; }
    unsigned char* ws = (unsigned char*)(GAS unsigned char*)args.ws;
    F.ctl = (gu32*)(ws + WS_CTL);
    F.kin = (KIN)__builtin_amdgcn_kernarg_segment_ptr(); F.ws = ws; F.out = (float*)(GAS float*)args.out;
    for (int u = F.tid; u < (LDS_BYTES - LDSCTL_OFF) / 4; u += NWAVES * 64) ((LAS unsigned*)(F.lds + LDSCTL_OFF))[u] = 0u;
    __syncthreads();
    const int lo = args.ph_lo, hi = args.ph_hi;
    const bool one_launch = (hi - lo) > 1;
    XcdBarrier bar; bar.bar = (unsigned*)(F.ctl + CW_BAR); bar.x = 0; bar.st = nullptr;
    if (one_launch) bar = xcd_barrier_post((unsigned*)(F.ctl + CW_BAR), F.MISC + 8);
#define IN(k) (lo <= (k) && (k) < hi)
#define PHASE_IDS() do { int t_ = threadIdx.x; asm volatile("" : "+v"(t_)); F.tid = t_; F.lane = t_ & 63; } while (0)
#define SEAM(k) do { if (IN(k) && IN((k) + 1)) xcd_barrier(bar); } while (0)

    if (IN(0)) { PHASE_IDS(); p0_prologue(F); } SEAM(0);
    if (IN(1)) { PHASE_IDS(); pg8::Gemm g{((bf16*)(F.ws + WS_SC)), ((bf16*)(F.ws + WS_WADA)), 256, NADA, DM}; pg8::StaticOrder S; S.init(256, NADA, F.G, (int)blockIdx.x);
        pg8::EpiF32Bias E{((float*)(F.ws + WS_MOD)), NADA, F.inp(13)};
        pg8::gemm_phase<pg8::EpiF32Bias, pg8::StaticOrder, PG8_ALIGN, PG8_SP2>(F.lds + RING_OFF, g, S, E); } SEAM(1);
    if (IN(2)) { PHASE_IDS(); norm_mod_rows(F, F.inp(0), F.inp(1), F.inp(10), 1024, 0); } SEAM(2);
    if (IN(3)) { PHASE_IDS(); pg8::Gemm g{((bf16*)(F.ws + WS_XN)), ((bf16*)(F.ws + WS_WIN)), MA, NIN, DM}; pg8::StaticOrder S; S.init(MA, NIN, F.G, (int)blockIdx.x);
        pg8::EpiBf16<0> E{((bf16*)(F.ws + WS_PROJ)), NIN, nullptr, 0, 0, 1.f};
        pg8::gemm_phase<pg8::EpiBf16<0>, pg8::StaticOrder, PG8_ALIGN, PG8_SP2>(F.lds + RING_OFF, g, S, E); } SEAM(3);
    if (IN(4)) { PHASE_IDS(); p4_phase(F); } SEAM(4);
    if (IN(5)) { PHASE_IDS();
        for (int it = 0;; ++it) {
            const int ld = F.vcu + (it >> 2) * F.G; if (ld >= 256) break;
            const int i = it & 3, bvh = ld >> 2, s = ld & 3, b = bvh >> 4, vh = bvh & 15, h = vh >> 2, c = (vh >> 1) & 1, half = vh & 1;
            const int qb = (i == 0) ? s : (i == 1) ? 7 - s : (i == 2) ? 8 + s : 15 - s;
            attn_body::attn_unit<8>(b, qb, (const attn_body::bf16*)((bf16*)(F.ws + WS_QB)) + h * 128 + c * 64, (const attn_body::bf16*)((bf16*)(F.ws + WS_KB)) + h * 128 + c * 64,
                                    (const attn_body::bf16*)((bf16*)(F.ws + WS_PROJ)) + 1024 + h * 128 + half * 64, (attn_body::bf16*)((bf16*)(F.ws + WS_OB)) + vh * 64, (char*)lds + RING_OFF);
        }
        PHASE_IDS();
        const float lam = diff_lambda(F);
        for (int u = F.vcu; u < 256; u += F.G) sattn_unit(F, u >> 1, u & 1, lam);
    } SEAM(5);
    if (IN(6)) { PHASE_IDS(); const float lam = diff_lambda(F); for (int tile = F.vcu; tile < MA / 64; tile += F.G) p6_tile(F, tile, lam); } SEAM(6);
    if (IN(7)) { PHASE_IDS(); pg8::Gemm g{((bf16*)(F.ws + WS_MIX)), ((bf16*)(F.ws + WS_WOUT)), MA, DM, DM}; pg8::StaticOrder S; S.init(MA, DM, F.G, (int)blockIdx.x);
        pg8::EpiResGate E{F.inp(0), F.inp(1), ((float*)(F.ws + WS_MOD)) + 2048, ((float*)(F.ws + WS_X1))};
        pg8::gemm_phase<pg8::EpiResGate, pg8::StaticOrder, PG8_ALIGN, PG8_SP2>(F.lds + RING_OFF, g, S, E); } SEAM(7);
    if (IN(8)) { PHASE_IDS(); norm_mod_rows(F, ((float*)(F.ws + WS_X1)), ((float*)(F.ws + WS_X1)) + (size_t)MP * DM, F.inp(11), 4096, 3072); } SEAM(8);
    if (IN(9)) { PHASE_IDS(); pg8::Gemm g{((bf16*)(F.ws + WS_XN)), ((bf16*)(F.ws + WS_WUP)), MA, NUP, DM}; pg8::StaticOrder S; S.init(MA, NUP, F.G, (int)blockIdx.x);
        pg8::EpiBf16<0> E{((bf16*)(F.ws + WS_UP)), NUP, nullptr, 0, 0, 1.f};
        pg8::gemm_phase<pg8::EpiBf16<0>, pg8::StaticOrder, PG8_ALIGN, PG8_SP2>(F.lds + RING_OFF, g, S, E); } SEAM(9);
    if (IN(10)) { PHASE_IDS(); p10_phase(F); } SEAM(10);
    if (IN(11)) { PHASE_IDS(); pg8::Gemm g{((bf16*)(F.ws + WS_ACT)), ((bf16*)(F.ws + WS_WDN)), MA, DM, DFF}; pg8::StaticOrder S; S.init(MA, DM, F.G, (int)blockIdx.x);
        pg8::EpiResGate E{((float*)(F.ws + WS_X1)), ((float*)(F.ws + WS_X1)) + (size_t)MP * DM, ((float*)(F.ws + WS_MOD)) + 5120, F.out};
        pg8::gemm_phase<pg8::EpiResGate, pg8::StaticOrder, PG8_ALIGN, PG8_SP2>(F.lds + RING_OFF, g, S, E); }
#undef IN
#undef SEAM
}

#ifndef MK_N_LAUNCHES
#define MK_N_LAUNCHES 1
#endif
extern "C" void kernel_launch(void* const* d_in, const int* in_sizes, int n_in, void* d_out, int out_size, void* d_ws, size_t ws_size, hipStream_t stream) {
    static int grid = 0;
    if (grid == 0) {
        if (n_in != 34 || out_size != (int)O_END || ws_size < WS_END) { fprintf(stderr, "kernel_launch: unexpected shapes: n_in %d out %d ws %zu\n", n_in, out_size, ws_size); grid = -1; return; }
        int dev = 0, cus = 0, per_cu = 0;
        if (hipGetDevice(&dev) != hipSuccess || hipDeviceGetAttribute(&cus, hipDeviceAttributeMultiprocessorCount, dev) != hipSuccess) { grid = -1; return; }
        if (hipFuncSetAttribute((const void*)mk_fwd, hipFuncAttributeMaxDynamicSharedMemorySize, LDS_BYTES) != hipSuccess) { fprintf(stderr, "kernel_launch: hipFuncSetAttribute failed\n"); grid = -1; return; }
        if (hipOccupancyMaxActiveBlocksPerMultiprocessor(&per_cu, (const void*)mk_fwd, NWAVES * 64, LDS_BYTES) != hipSuccess || per_cu < 1) { fprintf(stderr, "kernel_launch: occupancy query says %d\n", per_cu); }
        (void)hipGetLastError();
        grid = cus;
    }
    if (grid < 0) return;
    if (hipMemsetAsync((char*)d_ws + WS_CTL, 0, CTL_ZERO_BYTES, stream) != hipSuccess) return;
    Args a{};
    for (int i = 0; i < 34; ++i) a.in[i] = d_in[i];
    a.out = (float*)d_out; a.ws = (unsigned char*)d_ws;
    if (MK_N_LAUNCHES == 1) { a.ph_lo = 0; a.ph_hi = N_PHASES; hipLaunchKernelGGL(mk_fwd, dim3(grid), dim3(NWAVES * 64), LDS_BYTES, stream, a); }
    else { for (int p = 0; p < N_PHASES; ++p) { a.ph_lo = p; a.ph_hi = p + 1; hipLaunchKernelGGL(mk_fwd, dim3(grid), dim3(NWAVES * 64), LDS_BYTES, stream, a); } }
}
```

```cpp
#include <hip/hip_runtime.h>
#include <cstdio>
#include <cstdint>
namespace pg8 {
#define PG8_LAS __attribute__((address_space(3)))
typedef unsigned short bf16_t;
typedef short bf16x8 __attribute__((ext_vector_type(8)));
typedef float f32x4 __attribute__((ext_vector_type(4)));
typedef unsigned u32x4 __attribute__((ext_vector_type(4)));
constexpr int BM = 256, BK = 64, HALF = 128, HTB = HALF * BK * 2  , STAGE_BYTES = 8 * HTB, NXCD = 8, WGM = 8;

__host__ __device__ __forceinline__ int lds_byte(int r, int c) { const int st = (r >> 4) * 2 + (c >> 5), rr = r & 15, cc = c & 31, ob = rr * 64 + cc * 2; return st * 1024 + (ob ^ (((ob >> 9) & 1) << 5)); }
__host__ __device__ __forceinline__ void stage_rc(int b, int& R, int& C) { const int st = b / 1024, sb = b % 1024, swz = sb ^ (((sb >> 9) & 1) << 5); R = (st >> 1) * 16 + swz / 64; C = (st & 1) * 32 + (swz % 64) / 2; }
__host__ __device__ __forceinline__ int perm32(int rho) { const int n = rho >> 4, i = rho & 15; return 8 * (i >> 2) + 4 * n + (i & 3); }

struct Unit { int pm, pn; };
struct Gemm { const bf16_t* A; const bf16_t* Bt; int M, N, K; };

struct StaticOrder {
    int nM, nN, nwg, G, c;
    __host__ __device__ void init(int M, int N, int G_, int c_) { nM = M / BM; nN = N / BM; nwg = nM * nN; G = G_; c = c_; }
    __host__ __device__ bool next(int i, Unit& u) const {
        const long L = (long)i * G + c; if (L >= nwg) return false;
        int wgid = (int)L; { const int q = nwg / NXCD, r = nwg % NXCD, xcd = wgid % NXCD, off = wgid / NXCD; wgid = (xcd < r ? xcd * (q + 1) : r * (q + 1) + (xcd - r) * q) + off; }
        const int nig = WGM * nN, gid = wgid / nig, fm = gid * WGM, gsz = (nM - fm) < WGM ? (nM - fm) : WGM;
        u.pm = fm + ((wgid % nig) % gsz); u.pn = (wgid % nig) / gsz; return true;
    }
    __device__ __forceinline__ void a_ready(const Unit&) const {}
    __device__ __forceinline__ void done(const Unit&) const {}
};

__device__ __forceinline__ unsigned cvt_pk_bf16(float lo, float hi) { unsigned r; asm volatile("v_cvt_pk_bf16_f32 %0, %1, %2" : "=v"(r) : "v"(lo), "v"(hi)); return r; }
typedef float f32x2 __attribute__((ext_vector_type(2)));
__device__ __forceinline__ f32x2 gelu_pk(f32x2 v) {
    const f32x2 av = __builtin_elementwise_abs(v), d = av * 0.2316418882f + 1.0f;
    f32x2 t; t.x = __builtin_amdgcn_rcpf(d.x); t.y = __builtin_amdgcn_rcpf(d.y);
    f32x2 q = t * 0.5307027145f + (-0.7265760135f); q = q * t + 0.7107068705f; q = q * t + (-0.142248368f); q = q * t + 0.127414796f; q = q * t;
    const f32x2 s = (v * v) * (-0.72134752044f);
    f32x2 e; e.x = __builtin_amdgcn_exp2f(s.x); e.y = __builtin_amdgcn_exp2f(s.y);
    const f32x2 m = v * (q * e), r = v - m;
    f32x2 o; o.x = v.x < 0.f ? m.x : r.x; o.y = v.y < 0.f ? m.y : r.y; return o;
}

template <int ACT  > struct EpiBf16 {
    static constexpr bool PERM = true, AFTER_DRAIN = false; static_assert(ACT == 0 || ACT == 1, "EpiBf16: ACT is 0 (none) or 1 (gelu_pk)");
    bf16_t* O; int ldc; const float* bias; int split_cols; size_t split_stride; float scale0;
    __device__ __forceinline__ void operator()(const f32x4 (&acc)[2][2][4][2], const Unit& u, int wr, int wc, int fr, int fq) const {
        const int row0 = u.pm * BM + wr * 64 + fr; int colt = u.pn * BM; bf16_t* base = O;
        float sc = 1.f; if (split_cols) { const int t = colt / split_cols; base += (size_t)t * split_stride; colt -= t * split_cols; if (t == 0) sc = scale0; }
        const int col0 = colt + wc * 32 + 8 * fq, bcol0 = u.pn * BM + wc * 32 + 8 * fq;
        f32x4 bv[2][2];
#pragma unroll
        for (int bj = 0; bj < 2; ++bj)
#pragma unroll
            for (int n = 0; n < 2; ++n) bv[bj][n] = bias ? *(const f32x4*)(bias + bcol0 + bj * HALF + 4 * n) : (f32x4){0.f, 0.f, 0.f, 0.f};
#pragma unroll
        for (int ai = 0; ai < 2; ++ai)
#pragma unroll
            for (int m = 0; m < 4; ++m) { bf16_t* rowp = base + (size_t)(row0 + ai * HALF + m * 16) * ldc + col0;
#pragma unroll
                for (int bj = 0; bj < 2; ++bj) { f32x4 v0 = acc[ai][bj][m][0] + bv[bj][0], v1 = acc[ai][bj][m][1] + bv[bj][1];
                    if (ACT == 1) { f32x2 a = gelu_pk((f32x2){v0[0], v0[1]}), b = gelu_pk((f32x2){v0[2], v0[3]}), c = gelu_pk((f32x2){v1[0], v1[1]}), d = gelu_pk((f32x2){v1[2], v1[3]});
                        v0 = (f32x4){a.x, a.y, b.x, b.y}; v1 = (f32x4){c.x, c.y, d.x, d.y}; }
                    v0 = v0 * sc; v1 = v1 * sc; u32x4 w; w.x = cvt_pk_bf16(v0[0], v0[1]); w.y = cvt_pk_bf16(v0[2], v0[3]); w.z = cvt_pk_bf16(v1[0], v1[1]); w.w = cvt_pk_bf16(v1[2], v1[3]);
                    *(u32x4*)(rowp + bj * HALF) = w; } }
    }
};

constexpr int MPROMPT = 16384;
struct EpiF32Bias {
    static constexpr bool PERM = false, AFTER_DRAIN = false;
    float* out; int ldc; const float* bias;
    __device__ __forceinline__ void operator()(const f32x4 (&acc)[2][2][4][2], const Unit& u, int wr, int wc, int fr, int fq) const {
        const int col0 = u.pn * BM + wc * 32 + 4 * fq;
        f32x4 bv[2][2];
#pragma unroll
        for (int bj = 0; bj < 2; ++bj)
#pragma unroll
            for (int n = 0; n < 2; ++n) bv[bj][n] = *(const f32x4*)(bias + col0 + bj * HALF + n * 16);
#pragma unroll
        for (int ai = 0; ai < 2; ++ai)
#pragma unroll
            for (int m = 0; m < 4; ++m) { float* rp = out + (size_t)(u.pm * BM + ai * HALF + wr * 64 + m * 16 + fr) * ldc + col0;
#pragma unroll
                for (int bj = 0; bj < 2; ++bj)
#pragma unroll
                    for (int n = 0; n < 2; ++n) *(f32x4*)(rp + bj * HALF + n * 16) = acc[ai][bj][m][n] + bv[bj][n]; }
    }
};
struct EpiResGate {
    static constexpr bool PERM = false, AFTER_DRAIN = false;
    const float* bp; const float* bs;
    const float* gate;
    float* out;
    __device__ __forceinline__ void operator()(const f32x4 (&acc)[2][2][4][2], const Unit& u, int wr, int wc, int fr, int fq) const {
        const int col0 = u.pn * BM + wc * 32 + 4 * fq;
#pragma unroll
        for (int ai = 0; ai < 2; ++ai)
#pragma unroll
            for (int m = 0; m < 4; ++m) { const int row = u.pm * BM + ai * HALF + wr * 64 + m * 16 + fr;
                const float* b = (row < MPROMPT) ? bp + (size_t)row * 1024 : bs + (size_t)(row - MPROMPT) * 1024;
                const int mr = (row < MPROMPT) ? (row >> 12) : 4 + ((row - MPROMPT) >> 2);
                const float* g = gate + (size_t)mr * 6144; float* o = out + (size_t)row * 1024;
#pragma unroll
                for (int bj = 0; bj < 2; ++bj)
#pragma unroll
                    for (int n = 0; n < 2; ++n) { const int c = col0 + bj * HALF + n * 16; const f32x4 bb = *(const f32x4*)(b + c), gg = *(const f32x4*)(g + c);
                        *(f32x4*)(o + c) = bb + gg * acc[ai][bj][m][n]; }
                if (m & 1) asm volatile("" ::: "memory"); }
    }
};
template <class Epi, class Sched, bool ALIGN_EPI = false, bool SP2 = false>
__device__ __forceinline__ void gemm_phase(PG8_LAS unsigned char* lds, const Gemm g, const Sched& S, const Epi& E) {
    const int tid = threadIdx.x, wid = __builtin_amdgcn_readfirstlane(tid >> 6), lane = tid & 63, wr = wid >> 2, wc = wid & 3, fr = lane & 15, fq = lane >> 4;
    const int K = g.K, nt = K / BK;
    unsigned voffA[2], voffB[2];
#pragma unroll
    for (int i = 0; i < 2; ++i) { int R, C; stage_rc(tid * 16 + i * 8192, R, C); const int Rb = Epi::PERM ? ((R & ~31) + perm32(R & 31)) : R;
        voffA[i] = (unsigned)(R * K + C) * 2u; voffB[i] = (unsigned)(Rb * K + C) * 2u; }
    const size_t kstep = (size_t)(BK * 2);
    const size_t hstep = (size_t)HALF * K * 2;
    const size_t tstep = 2 * hstep;
    const unsigned ldsw = (unsigned)wid * 1024u;
    const int aoff = lds_byte(wr * 64 + fr, fq * 8), boff = lds_byte(wc * 32 + fr, fq * 8);
#define PG8_SA(b, h) (((b) * 2 + (h)) * HTB)
#define PG8_SB(b, h) ((4 + (b) * 2 + (h)) * HTB)
#define PG8_STAGE(bufoff, gbase, voff) do { _Pragma("unroll") for (int _i = 0; _i < 2; ++_i) \
        __builtin_amdgcn_global_load_lds((const unsigned*)((const char*)(gbase) + (voff)[_i]), (PG8_LAS unsigned*)(lds + (bufoff) + ldsw + _i * 8192), 16, 0, 0); } while (0)
#define PG8_LDA(dst, b, h) do { _Pragma("unroll") for (int m = 0; m < 4; ++m) _Pragma("unroll") for (int k = 0; k < 2; ++k) dst[m][k] = *(const PG8_LAS bf16x8*)(lds + PG8_SA(b, h) + aoff + m * 2048 + k * 1024); } while (0)
#define PG8_LDB(dst, b, h) do { _Pragma("unroll") for (int n = 0; n < 2; ++n) _Pragma("unroll") for (int k = 0; k < 2; ++k) dst[n][k] = *(const PG8_LAS bf16x8*)(lds + PG8_SB(b, h) + boff + n * 2048 + k * 1024); } while (0)
#define PG8_MMA(ai, bj, At, Bt) do { __builtin_amdgcn_s_setprio(1); _Pragma("unroll") for (int m = 0; m < 4; ++m) _Pragma("unroll") for (int n = 0; n < 2; ++n) _Pragma("unroll") for (int k = 0; k < 2; ++k) \
        acc[ai][bj][m][n] = __builtin_amdgcn_mfma_f32_16x16x32_bf16(Bt[n][k], At[m][k], acc[ai][bj][m][n], 0, 0, 0); __builtin_amdgcn_s_setprio(0); } while (0)
#define PG8_WAIT_V(n) asm volatile("s_waitcnt vmcnt(" #n ")" ::: "memory")
#define PG8_WAIT_L(n) asm volatile("s_waitcnt lgkmcnt(" #n ")" ::: "memory")
#define PG8_BAR __builtin_amdgcn_s_barrier()
#define PG8_SCHED __builtin_amdgcn_sched_barrier(0)
    Unit cur, nxt; int ui = 0;
    if (!S.next(0, cur)) return;
    f32x4 acc[2][2][4][2];
#pragma unroll
    for (int a = 0; a < 2; ++a)
#pragma unroll
        for (int b = 0; b < 2; ++b)
#pragma unroll
            for (int m = 0; m < 4; ++m)
#pragma unroll
                for (int n = 0; n < 2; ++n) acc[a][b][m][n] = (f32x4){0.f, 0.f, 0.f, 0.f};
    bf16x8 At[4][2], B0[2][2], B1[2][2];
    const char* cA = (const char*)g.A + (size_t)cur.pm * tstep; const char* cB = (const char*)g.Bt + (size_t)cur.pn * tstep;
    S.a_ready(cur);
    if constexpr (SP2) {
        PG8_STAGE(PG8_SB(0, 0), cB, voffB); PG8_STAGE(PG8_SB(0, 1), cB + hstep, voffB); PG8_STAGE(PG8_SA(0, 0), cA, voffA); PG8_STAGE(PG8_SA(0, 1), cA + hstep, voffA);
        if (wr == 1) PG8_BAR;
        PG8_WAIT_V(2); PG8_BAR;
        PG8_STAGE(PG8_SB(1, 0), cB + kstep, voffB); PG8_STAGE(PG8_SA(1, 0), cA + kstep, voffA); PG8_STAGE(PG8_SB(1, 1), cB + hstep + kstep, voffB);
        PG8_WAIT_V(6); PG8_BAR;
    } else {
        PG8_STAGE(PG8_SB(0, 0), cB, voffB); PG8_STAGE(PG8_SA(0, 0), cA, voffA); PG8_STAGE(PG8_SB(0, 1), cB + hstep, voffB); PG8_STAGE(PG8_SA(0, 1), cA + hstep, voffA);
        if (wr == 1) PG8_BAR;
        PG8_WAIT_V(4); PG8_BAR;
        PG8_STAGE(PG8_SB(1, 0), cB + kstep, voffB); PG8_STAGE(PG8_SA(1, 0), cA + kstep, voffA); PG8_STAGE(PG8_SB(1, 1), cB + hstep + kstep, voffB);
        PG8_WAIT_V(6); PG8_BAR;
    }
    for (;;) {
        const bool has_next = S.next(ui + 1, nxt);
        const char* nA = has_next ? (const char*)g.A + (size_t)nxt.pm * tstep : cA; const char* nB = has_next ? (const char*)g.Bt + (size_t)nxt.pn * tstep : cB;
        for (int t = 0; t < nt; t += 2) {
            const bool last = (t == nt - 2);
            const char* a1 = cA + (size_t)(t + 1) * kstep;
            const char* a2 = last ? nA : cA + (size_t)(t + 2) * kstep; const char* b2 = last ? nB : cB + (size_t)(t + 2) * kstep;
            const char* a3 = a2 + kstep; const char* b3 = b2 + kstep;
            if (last && has_next) S.a_ready(nxt);
            if constexpr (SP2) {
            PG8_LDB(B0, 0, 0); PG8_LDB(B1, 0, 1); PG8_SCHED; PG8_LDA(At, 0, 0); PG8_STAGE(PG8_SA(1, 1), a1 + hstep, voffA);
            PG8_WAIT_V(8); PG8_WAIT_L(0); PG8_BAR; PG8_MMA(0, 0, At, B0); PG8_MMA(0, 1, At, B1); PG8_BAR; PG8_SCHED;
            PG8_LDA(At, 0, 1); PG8_STAGE(PG8_SB(0, 0), b2, voffB); PG8_STAGE(PG8_SB(0, 1), b2 + hstep, voffB); PG8_STAGE(PG8_SA(0, 0), a2, voffA);
            PG8_WAIT_V(8); PG8_WAIT_L(0); PG8_BAR; PG8_MMA(1, 0, At, B0); PG8_MMA(1, 1, At, B1); PG8_BAR; PG8_SCHED;
            PG8_LDB(B0, 1, 0); PG8_LDB(B1, 1, 1); PG8_SCHED; PG8_LDA(At, 1, 0); PG8_STAGE(PG8_SA(0, 1), a2 + hstep, voffA);
            PG8_WAIT_V(8); PG8_WAIT_L(0); PG8_BAR; PG8_MMA(0, 0, At, B0); PG8_MMA(0, 1, At, B1); PG8_BAR; PG8_SCHED;
            PG8_LDA(At, 1, 1); PG8_STAGE(PG8_SB(1, 0), b3, voffB); PG8_STAGE(PG8_SB(1, 1), b3 + hstep, voffB); PG8_STAGE(PG8_SA(1, 0), a3, voffA);
            PG8_WAIT_V(8); PG8_WAIT_L(0); PG8_BAR; PG8_MMA(1, 0, At, B0); PG8_MMA(1, 1, At, B1); PG8_BAR; PG8_SCHED;
            } else {
            PG8_LDB(B0, 0, 0); PG8_SCHED; PG8_LDA(At, 0, 0); PG8_STAGE(PG8_SA(1, 1), a1 + hstep, voffA);
            PG8_WAIT_L(8); PG8_BAR; PG8_WAIT_L(0); PG8_MMA(0, 0, At, B0); PG8_BAR; PG8_SCHED;
            PG8_LDB(B1, 0, 1); PG8_STAGE(PG8_SB(0, 0), b2, voffB);
            PG8_BAR; PG8_WAIT_L(0); PG8_MMA(0, 1, At, B1); PG8_BAR;
            PG8_LDA(At, 0, 1); PG8_STAGE(PG8_SA(0, 0), a2, voffA);
            PG8_BAR; PG8_WAIT_L(0); PG8_MMA(1, 0, At, B0); PG8_BAR; PG8_SCHED;
            PG8_STAGE(PG8_SB(0, 1), b2 + hstep, voffB);
            PG8_WAIT_V(6); PG8_BAR; PG8_MMA(1, 1, At, B1); PG8_BAR;
            PG8_LDB(B0, 1, 0); PG8_SCHED; PG8_LDA(At, 1, 0); PG8_STAGE(PG8_SA(0, 1), a2 + hstep, voffA);
            PG8_WAIT_L(8); PG8_BAR; PG8_WAIT_L(0); PG8_MMA(0, 0, At, B0); PG8_BAR; PG8_SCHED;
            PG8_LDB(B1, 1, 1); PG8_STAGE(PG8_SB(1, 0), b3, voffB);
            PG8_BAR; PG8_WAIT_L(0); PG8_MMA(0, 1, At, B1); PG8_BAR;
            PG8_LDA(At, 1, 1); PG8_STAGE(PG8_SA(1, 0), a3, voffA);
            PG8_BAR; PG8_WAIT_L(0); PG8_MMA(1, 0, At, B0); PG8_BAR; PG8_SCHED;
            PG8_STAGE(PG8_SB(1, 1), b3 + hstep, voffB);
            PG8_WAIT_V(6); PG8_BAR; PG8_MMA(1, 1, At, B1); PG8_BAR;
            }
        }
        if constexpr (ALIGN_EPI) { if (wr == 0) PG8_BAR; }
        if constexpr (!Epi::AFTER_DRAIN) { E(acc, cur, wr, wc, fr, fq); S.done(cur); }
        if (!has_next) break;
#pragma unroll
        for (int a = 0; a < 2; ++a)
#pragma unroll
            for (int b = 0; b < 2; ++b)
#pragma unroll
                for (int m = 0; m < 4; ++m)
#pragma unroll
                    for (int n = 0; n < 2; ++n) acc[a][b][m][n] = (f32x4){0.f, 0.f, 0.f, 0.f};
        cur = nxt; cA = nA; cB = nB; ++ui;
        if constexpr (ALIGN_EPI) { if (wr == 1) PG8_BAR; }
    }
    PG8_WAIT_V(0);
    if constexpr (!ALIGN_EPI) { if (wr == 0) PG8_BAR; }
    PG8_BAR;
    if constexpr (Epi::AFTER_DRAIN) { E.fused(acc, cur, wr, wc, fr, fq, lds, wid, lane); S.done(cur); }
#undef PG8_SA
#undef PG8_SB
#undef PG8_STAGE
#undef PG8_LDA
#undef PG8_LDB
#undef PG8_MMA
#undef PG8_WAIT_V
#undef PG8_WAIT_L
#undef PG8_BAR
#undef PG8_SCHED
}
}

#ifndef PG8_SP2
#define PG8_SP2 true
#endif
#ifndef PG8_ALIGN
#define PG8_ALIGN true
#endif
#include <hip/hip_bf16.h>
#include <cmath>
namespace attn_body {
using bf16=__hip_bfloat16;
using bf16x8=__attribute__((ext_vector_type(8)))short;
using s16x4=__attribute__((ext_vector_type(4)))short;
using f32x16=__attribute__((ext_vector_type(16)))float;
using u32x4=__attribute__((ext_vector_type(4)))unsigned;
constexpr int SEQ=4096,D=64; constexpr int QP=512,KP=512,VP=2560,OP=1024;
constexpr int NW=8,QBLK=32,QB=QBLK*NW,KVBLK=64,NQB=SEQ/QB;
constexpr int ATTN_UNIT_ROWS=QB;
__device__ __forceinline__ int crow(int r,int hi){return (r&3)+8*(r>>2)+4*hi;}
#define SBAR() __builtin_amdgcn_sched_barrier(0)
__device__ __forceinline__ void cmask(f32x16&p0,f32x16&p1,int jb,int qrel,int hi){
  const float NEG=-INFINITY; int kb=64*jb+4*hi;
  #pragma unroll
  for(int r=0;r<16;++r){int kv=kb+(r&3)+8*(r>>2); if(kv>qrel)p0[r]=NEG; if(kv+32>qrel)p1[r]=NEG;}
}

constexpr int NSLOT=3, SLOTB=8192;
constexpr int LDS_K=0, LDS_V=NSLOT*SLOTB, LDS_WS=2*NSLOT*SLOTB, LDS_OST=LDS_WS+NW*64*4, LDS_BYTES=LDS_OST+NW*4096;
constexpr float C2=0.125f*1.4426950408889634f;
__device__ __forceinline__ void glds16(const void*gsrc,unsigned lds_dst){unsigned keep;
  asm volatile("s_mov_b32 %0, m0\n\ts_mov_b32 m0, %2\n\ts_nop 0\n\tglobal_load_lds_dwordx4 %1, off\n\ts_mov_b32 m0, %0":"=&s"(keep):"v"(gsrc),"s"(lds_dst):"memory");}
__device__ __forceinline__ float max3f(float a,float b,float c){float r;asm("v_max3_f32 %0, %1, %2, %3":"=v"(r):"v"(a),"v"(b),"v"(c));return r;}
__device__ __forceinline__ float max2f(float a,float b){float r;asm("v_max_f32_e32 %0, %1, %2":"=v"(r):"v"(a),"v"(b));return r;}
__device__ __forceinline__ float fadd_s(float a,float b){float r;asm("v_add_f32_e32 %0, %1, %2":"=v"(r):"v"(a),"v"(b));return r;}
__device__ __forceinline__ float fsub_s(float a,float b){float r;asm("v_sub_f32_e32 %0, %1, %2":"=v"(r):"v"(a),"v"(b));return r;}
typedef float f32x2_t __attribute__((ext_vector_type(2))); typedef __bf16 bf16x2_t __attribute__((ext_vector_type(2)));
__device__ __forceinline__ unsigned cvtpk_s(float lo,float hi){f32x2_t v={lo,hi};bf16x2_t b=__builtin_convertvector(v,bf16x2_t);return __builtin_bit_cast(unsigned,b);}
#define WAIT_BAR(N) asm volatile("s_waitcnt vmcnt(" #N ") lgkmcnt(0)\n\ts_barrier":::"memory")

__device__ __forceinline__ void qkt(f32x16&p0,f32x16&p1,const char*Kslot,const bf16x8*qr,const f32x16&negm,int r32,int hi){
  const char*kb=Kslot+hi*1024+r32*16;
  #pragma unroll
  for(int d0=0;d0<4;++d0){
    const bf16x8 b0=*reinterpret_cast<const bf16x8*>(kb+d0*2048);
    const bf16x8 b1=*reinterpret_cast<const bf16x8*>(kb+d0*2048+512);
    if(d0==0){p0=__builtin_amdgcn_mfma_f32_32x32x16_bf16(b0,qr[0],negm,0,0,0);p1=__builtin_amdgcn_mfma_f32_32x32x16_bf16(b1,qr[0],negm,0,0,0);}
    else{p0=__builtin_amdgcn_mfma_f32_32x32x16_bf16(b0,qr[d0],p0,0,0,0);p1=__builtin_amdgcn_mfma_f32_32x32x16_bf16(b1,qr[d0],p1,0,0,0);}}
}
typedef __attribute__((address_space(3))) const char* lds_cptr;
typedef short v4i16_t __attribute__((ext_vector_type(4)));
__device__ __forceinline__ void kload8(bf16x8*kf,lds_cptr kp){
  kf[0]=*(const __attribute__((address_space(3))) bf16x8*)(kp);      kf[1]=*(const __attribute__((address_space(3))) bf16x8*)(kp+512);
  kf[2]=*(const __attribute__((address_space(3))) bf16x8*)(kp+2048); kf[3]=*(const __attribute__((address_space(3))) bf16x8*)(kp+2560);
  kf[4]=*(const __attribute__((address_space(3))) bf16x8*)(kp+4096); kf[5]=*(const __attribute__((address_space(3))) bf16x8*)(kp+4608);
  kf[6]=*(const __attribute__((address_space(3))) bf16x8*)(kp+6144); kf[7]=*(const __attribute__((address_space(3))) bf16x8*)(kp+6656);
}
__device__ __forceinline__ void kload2(bf16x8*kf,lds_cptr kp,int j){ kf[2*j]=*(const __attribute__((address_space(3))) bf16x8*)(kp+j*2048); kf[2*j+1]=*(const __attribute__((address_space(3))) bf16x8*)(kp+j*2048+512); }
__device__ __forceinline__ s16x4 vtr(lds_cptr p){ return __builtin_bit_cast(s16x4,__builtin_amdgcn_ds_read_tr16_b64_v4i16((__attribute__((address_space(3))) v4i16_t*)p)); }
__device__ __forceinline__ float rowmax(const f32x16&p0,const f32x16&p1){
  float a=max3f(p0[0],p0[1],p1[0]),b=max3f(p0[2],p0[3],p1[1]);a=max3f(a,p1[2],p1[3]);
  #pragma unroll
  for(int r=4;r<16;r+=4){a=max3f(a,p0[r],p0[r+1]);b=max3f(b,p0[r+2],p0[r+3]);a=max3f(a,p1[r],p1[r+1]);b=max3f(b,p1[r+2],p1[r+3]);}
  const float m=max2f(a,b);
  auto rr=__builtin_amdgcn_permlane32_swap(__float_as_uint(m),__float_as_uint(m),false,false);
  return max2f(__uint_as_float(rr[0]),__uint_as_float(rr[1]));
}
__device__ __forceinline__ void pv(f32x16*o,int vb,bf16x8 pa0,bf16x8 pa1,bf16x8 pa2,bf16x8 pa3){
  #pragma unroll
  for(int d0=0;d0<2;++d0){s16x4 lo[4],hi[4];
    #pragma unroll
    for(int ks=0;ks<4;++ks){
      asm volatile("ds_read_b64_tr_b16 %0,%1 offset:%c2":"=&v"(lo[ks]):"v"(vb),"i"(d0*4096+ks*1024):"memory");
      asm volatile("ds_read_b64_tr_b16 %0,%1 offset:%c2":"=&v"(hi[ks]):"v"(vb),"i"(d0*4096+ks*1024+512):"memory");}
    asm volatile("s_waitcnt lgkmcnt(0)":::"memory");SBAR();
    #define PK(k) (bf16x8){lo[k][0],lo[k][1],lo[k][2],lo[k][3],hi[k][0],hi[k][1],hi[k][2],hi[k][3]}
    o[d0]=__builtin_amdgcn_mfma_f32_32x32x16_bf16(pa0,PK(0),o[d0],0,0,0);
    o[d0]=__builtin_amdgcn_mfma_f32_32x32x16_bf16(pa1,PK(1),o[d0],0,0,0);
    o[d0]=__builtin_amdgcn_mfma_f32_32x32x16_bf16(pa2,PK(2),o[d0],0,0,0);
    o[d0]=__builtin_amdgcn_mfma_f32_32x32x16_bf16(pa3,PK(3),o[d0],0,0,0);
    #undef PK
  }
}

#ifndef ATTN_STORE16
#define ATTN_STORE16(p,v) (*(u32x4*)(p)=(v))
#endif
template<int THRL> __device__ __forceinline__ void attn_unit(int b,int qb,const bf16*Q,const bf16*__restrict__ K,const bf16*__restrict__ V,bf16*O,char*shm){
  int tid_=threadIdx.x; asm volatile("":"+v"(tid_)); const int tid=tid_,lane=tid&63,r32=lane&31,hi=lane>>5; const int wid=__builtin_amdgcn_readfirstlane(tid>>6);
  const long rowbase=(long)b*SEQ; const int q0=qb*QB;
  const bf16*Qw=Q+(rowbase+q0+wid*QBLK)*QP;
  const bf16*Kh=K+rowbase*KP,*Vh=V+rowbase*VP;
  const unsigned lds0=(unsigned)(uintptr_t)shm;
  float*wsf=(float*)(shm+LDS_WS)+wid*64;
  const bf16*ksrc=Kh+(long)lane*KP+wid*8;
  const bf16*vsrc=Vh+(long)(16*(wid&3)+(lane>>2))*VP+(wid>>2)*32+(lane&3)*8;
  const unsigned kdst=lds0+LDS_K+wid*1024, vdst=lds0+LDS_V+wid*1024;
  #define DMA_K(t,slot) glds16(ksrc+(long)(t)*KVBLK*KP,(unsigned)__builtin_amdgcn_readfirstlane(kdst+(slot)))
  #define DMA_V(t,slot) glds16(vsrc+(long)(t)*KVBLK*VP,(unsigned)__builtin_amdgcn_readfirstlane(vdst+(slot)))
  const int vb0=(int)(lds0+LDS_V)+((lane>>4)&1)*32+(lane&3)*8+(4*hi+((lane&15)>>2))*64;
  const char*Kbase=shm+LDS_K; bf16x8 kf[8];
  const lds_cptr shm3=(lds_cptr)shm; const lds_cptr kp0=shm3+LDS_K+hi*1024+r32*16; const lds_cptr vp0=shm3+LDS_V+((lane>>4)&1)*32+(lane&3)*8+(4*hi+((lane&15)>>2))*64;
  const int NT=(q0+QB)/KVBLK;
  DMA_K(0,0);DMA_V(0,0);DMA_K(1,SLOTB);
  bf16x8 qr[4];
  #pragma unroll
  for(int d0=0;d0<4;++d0)qr[d0]=*reinterpret_cast<const bf16x8*>(&Qw[(long)r32*QP+d0*16+hi*8]);
  float mhat=0.f,l_reg=0.f;f32x16 o[2];f32x16 negm; { float z_=0.f; asm volatile("":"+v"(z_)); _Pragma("unroll") for(int r=0;r<16;++r){o[0][r]=z_;o[1][r]=z_;negm[r]=z_;} } asm volatile("":"+v"(negm));
  const int qrel=wid*QBLK+r32;
  #define CMASK(P0,P1,t) do{int jb_=(t)-(NT-4); if(jb_>=0)cmask(P0,P1,jb_,qrel,hi);}while(0)
  bool resc=false;
  #define START(P0,P1) do{ const float rm=rowmax(P0,P1); resc=false; \
    { const float dl=rm; mhat=fadd_s(mhat,dl); \
      _Pragma("unroll") for(int r=0;r<16;++r){P0[r]=fsub_s(P0[r],dl);P1[r]=fsub_s(P1[r],dl);} \
      _Pragma("unroll") for(int r=0;r<16;++r)negm[r]=-mhat; asm volatile("":"+v"(negm)); } \
    _Pragma("unroll") for(int r=0;r<16;++r)P0[r]=__builtin_amdgcn_exp2f(P0[r]); }while(0)
  #define RESC() do{ if(resc){ asm volatile("s_waitcnt lgkmcnt(0)":::"memory"); \
      _Pragma("unroll") for(int d_=0;d_<2;++d_) _Pragma("unroll") for(int r=0;r<16;++r)o[d_][r]*=wsf[crow(r,hi)]; } }while(0)
  f32x16 pA0,pA1,pB0,pB1;
  int sl_prev=0,sl_cur=0,sl_next=SLOTB;
  #define ROT() do{sl_prev=sl_cur;sl_cur=sl_next;sl_next=(sl_next==(NSLOT-1)*SLOTB)?0:sl_next+SLOTB;}while(0)
  DMA_K(2,2*SLOTB);
  WAIT_BAR(3);
  qkt(pA0,pA1,Kbase,qr,negm,r32,hi);asm volatile("s_nop 15\n\ts_nop 7":"+v"(pA0),"+v"(pA1));CMASK(pA0,pA1,0);
  START(pA0,pA1);
  _Pragma("unroll") for(int r=0;r<16;++r)pA1[r]=__builtin_amdgcn_exp2f(pA1[r]);
  WAIT_BAR(0);
  DMA_K(3,0);DMA_V(1,SLOTB);
  ROT();
  kload8(kf,kp0+sl_cur);
  WAIT_BAR(2);
  s16x4 vlo[8],vhi[8]; u32x4 pw0,pw1,pw2,pw3;
  #define PKW(P,B) cvtpk_s(P[B],P[B+1])
  #define PAF(k) __builtin_bit_cast(bf16x8,pw##k)
  #define VFR(i) (bf16x8){vlo[i][0],vlo[i][1],vlo[i][2],vlo[i][3],vhi[i][0],vhi[i][1],vhi[i][2],vhi[i][3]}
  #define PIN(x) asm volatile("":"+v"(x))
  #define MX3(a,b,c) __builtin_fmaxf(__builtin_fmaxf((a),(b)),(c))
  #define GAPA(MF,A0,A1,A2,A3,W0,W1,PW) do{ MF; sacc+=A0; sacc+=A1; sacc+=A2; sacc+=A3; PIN(sacc); W0; W1; PIN(PW); SBAR(); }while(0)
  #define EX(v) __builtin_amdgcn_exp2f(v)
  #define GAPB(MF,X,B) do{ MF; X[B]=EX(X[B]); X[B+1]=EX(X[B+1]); X[B+2]=EX(X[B+2]); X[B+3]=EX(X[B+3]); PIN(X); SBAR(); }while(0)
  #define VRD(i) do{ vlo[i]=vtr(vp_+(((i)>>2)*4096+((i)&3)*1024)); vhi[i]=vtr(vp_+(((i)>>2)*4096+((i)&3)*1024+512)); }while(0)
  #define KRD(G,j) do{ if(G){ kload2(kf,kp0+sl_next,j); SBAR(); } }while(0)
  #define STEP(C0,C1,P0,P1,t,GK,GV,GL) do{ SBAR(); \
    const lds_cptr vp_=vp0+sl_prev; \
    VRD(0); SBAR(); float sacc=(P0[0]+P0[1]); \
    GAPA(C0=__builtin_amdgcn_mfma_f32_32x32x16_bf16(kf[0],qr[0],negm,0,0,0), P0[2],P0[3],P0[4],P0[5],     pw0[0]=PKW(P0,0), pw0[1]=PKW(P0,2), pw0); \
    VRD(4); SBAR(); GAPA(C1=__builtin_amdgcn_mfma_f32_32x32x16_bf16(kf[1],qr[0],negm,0,0,0), P0[6],P0[7],P0[8],P0[9],     pw0[2]=PKW(P0,4), pw0[3]=PKW(P0,6), pw0); \
    VRD(1); SBAR(); GAPA(C0=__builtin_amdgcn_mfma_f32_32x32x16_bf16(kf[2],qr[1],C0,0,0,0),   P0[10],P0[11],P0[12],P0[13], pw1[0]=PKW(P0,8), pw1[1]=PKW(P0,10), pw1); \
    VRD(5); SBAR(); GAPA(C1=__builtin_amdgcn_mfma_f32_32x32x16_bf16(kf[3],qr[1],C1,0,0,0),   P0[14],P0[15],P1[0],P1[1],   pw1[2]=PKW(P0,12),pw1[3]=PKW(P0,14), pw1); \
    VRD(2); SBAR(); GAPA(C0=__builtin_amdgcn_mfma_f32_32x32x16_bf16(kf[4],qr[2],C0,0,0,0),   P1[2],P1[3],P1[4],P1[5],     pw2[0]=PKW(P1,0), pw2[1]=PKW(P1,2), pw2); \
    VRD(6); SBAR(); GAPA(C1=__builtin_amdgcn_mfma_f32_32x32x16_bf16(kf[5],qr[2],C1,0,0,0),   P1[6],P1[7],P1[8],P1[9],     pw2[2]=PKW(P1,4), pw2[3]=PKW(P1,6), pw2); \
    VRD(3); SBAR(); GAPA(C0=__builtin_amdgcn_mfma_f32_32x32x16_bf16(kf[6],qr[3],C0,0,0,0),   P1[10],P1[11],P1[12],P1[13], pw3[0]=PKW(P1,8), pw3[1]=PKW(P1,10), pw3); \
    VRD(7); SBAR(); GAPA(C1=__builtin_amdgcn_mfma_f32_32x32x16_bf16(kf[7],qr[3],C1,0,0,0),   P1[14],P1[15],0.f,0.f,       pw3[2]=PKW(P1,12),pw3[3]=PKW(P1,14), pw3); \
    l_reg+=sacc; \
    if(GK){DMA_K((t)+3,sl_cur);} if(GV){DMA_V((t)+1,sl_next);} \
    CMASK(C0,C1,t); \
    { float a=MX3(C0[0],C0[1],C1[0]),b=MX3(C0[2],C0[3],C1[1]); a=MX3(a,C1[2],C1[3]); \
      _Pragma("unroll") for(int r=4;r<16;r+=4){a=MX3(a,C0[r],C0[r+1]);b=MX3(b,C0[r+2],C0[r+3]);a=MX3(a,C1[r],C1[r+1]);b=MX3(b,C1[r+2],C1[r+3]);} \
      float rm=__builtin_fmaxf(a,b); { auto rr=__builtin_amdgcn_permlane32_swap(__float_as_uint(rm),__float_as_uint(rm),false,false); rm=__builtin_fmaxf(__uint_as_float(rr[0]),__uint_as_float(rr[1])); } \
      resc=false; \
      if(__builtin_expect(__any(rm>(float)THRL),0)){ const float dl=__builtin_fmaxf(rm,0.f); mhat+=dl; \
        _Pragma("unroll") for(int r=0;r<16;++r){C0[r]-=dl;C1[r]-=dl;} \
        _Pragma("unroll") for(int r=0;r<16;++r)negm[r]=-mhat; asm volatile("":"+v"(negm)); \
        const float f=__builtin_amdgcn_exp2f(-dl); l_reg*=f; if(hi==0)wsf[r32]=f; resc=true; } } \
    SBAR(); \
    GAPB(o[0]=__builtin_amdgcn_mfma_f32_32x32x16_bf16(PAF(0),VFR(0),o[0],0,0,0), C0,0); \
    GAPB(o[1]=__builtin_amdgcn_mfma_f32_32x32x16_bf16(PAF(0),VFR(4),o[1],0,0,0), C0,4); \
    KRD(GL,0); GAPB(o[0]=__builtin_amdgcn_mfma_f32_32x32x16_bf16(PAF(1),VFR(1),o[0],0,0,0), C0,8); \
    KRD(GL,1); GAPB(o[1]=__builtin_amdgcn_mfma_f32_32x32x16_bf16(PAF(1),VFR(5),o[1],0,0,0), C0,12); \
    KRD(GL,2); GAPB(o[0]=__builtin_amdgcn_mfma_f32_32x32x16_bf16(PAF(2),VFR(2),o[0],0,0,0), C1,0); \
    KRD(GL,3); GAPB(o[1]=__builtin_amdgcn_mfma_f32_32x32x16_bf16(PAF(2),VFR(6),o[1],0,0,0), C1,4); \
    GAPB(o[0]=__builtin_amdgcn_mfma_f32_32x32x16_bf16(PAF(3),VFR(3),o[0],0,0,0), C1,8); \
    GAPB(o[1]=__builtin_amdgcn_mfma_f32_32x32x16_bf16(PAF(3),VFR(7),o[1],0,0,0), C1,12); \
    }while(0)
  int t=1;
  #undef CMASK
  #define CMASK(P0,P1,t) do{}while(0)
  for(;t+5<NT;t+=2){
    STEP(pB0,pB1,pA0,pA1,t,true,true,true);     WAIT_BAR(2); RESC(); ROT();
    STEP(pA0,pA1,pB0,pB1,t+1,true,true,true);   WAIT_BAR(2); RESC(); ROT();
  }
  #undef CMASK
  #define CMASK(P0,P1,t) do{int jb_=(t)-(NT-4); if(jb_>=0)cmask(P0,P1,jb_,qrel,hi);}while(0)
  #define ENDW(tt) do{ if((tt)+3<NT){WAIT_BAR(2);} else if((tt)+2<NT){WAIT_BAR(1);} else {WAIT_BAR(0);} }while(0)
  for(;t+1<NT;t+=2){
    STEP(pB0,pB1,pA0,pA1,t,(t+3<NT),(t+1<NT),(t+1<NT));       ENDW(t);   RESC(); ROT();
    STEP(pA0,pA1,pB0,pB1,t+1,(t+4<NT),(t+2<NT),(t+2<NT));     ENDW(t+1); RESC(); ROT();
  }
  STEP(pB0,pB1,pA0,pA1,NT-1,false,false,false); RESC();
  { float sacc=pB0[0]+pB0[1]; _Pragma("unroll") for(int r=2;r<16;++r)sacc+=pB0[r]; _Pragma("unroll") for(int r=0;r<16;++r)sacc+=pB1[r]; l_reg+=sacc;
    pw0=(u32x4){PKW(pB0,0),PKW(pB0,2),PKW(pB0,4),PKW(pB0,6)};pw1=(u32x4){PKW(pB0,8),PKW(pB0,10),PKW(pB0,12),PKW(pB0,14)};pw2=(u32x4){PKW(pB1,0),PKW(pB1,2),PKW(pB1,4),PKW(pB1,6)};pw3=(u32x4){PKW(pB1,8),PKW(pB1,10),PKW(pB1,12),PKW(pB1,14)};
    SBAR(); pv(o,vb0+sl_cur,PAF(0),PAF(1),PAF(2),PAF(3)); }
  #undef PKW
  #undef PAF
  #undef VFR
  #undef PIN
  #undef MX3
  #undef GAPA
  #undef GAPB
  #undef EX
  #undef VRD
  #undef KRD
  #undef STEP
  #undef ENDW
  {auto rr=__builtin_amdgcn_permlane32_swap(__float_as_uint(l_reg),__float_as_uint(l_reg),false,false);l_reg=__uint_as_float(rr[0])+__uint_as_float(rr[1]);}
  if(hi==0)wsf[32+r32]=l_reg;asm volatile("s_waitcnt lgkmcnt(0)":::"memory");
  float rli[16];
  #pragma unroll
  for(int r=0;r<16;++r)rli[r]=__builtin_amdgcn_rcpf(wsf[32+crow(r,hi)]);
  bf16*Ow=O+(rowbase+q0+wid*QBLK)*OP;
  { bf16*stg=(bf16*)(shm+LDS_OST)+wid*2048;
    #pragma unroll
    for(int r=0;r<16;++r){const int orow=crow(r,hi);
      #pragma unroll
      for(int d0=0;d0<2;++d0)stg[orow*64+d0*32+r32]=__float2bfloat16(o[d0][r]*rli[r]);}
    asm volatile("s_waitcnt lgkmcnt(0)":::"memory");
    #pragma unroll
    for(int i=0;i<4;++i){const int row=i*8+(lane>>3),ch=lane&7; const u32x4 v=*(const u32x4*)(stg+row*64+ch*8); ATTN_STORE16(Ow+(long)row*OP+ch*8,v);} }
  asm volatile("s_waitcnt lgkmcnt(0)\n\ts_barrier":::"memory");
  #undef DMA_K
  #undef DMA_V
  #undef CMASK
  #undef START
  #undef RESC
  #undef ROT
}
constexpr int ATTN_LDS_BYTES=LDS_BYTES;
#undef SBAR
#undef WAIT_BAR
}
#define GAS __attribute__((address_space(1)))
#define LAS __attribute__((address_space(3)))
typedef unsigned short bf16;
typedef unsigned v4u __attribute__((ext_vector_type(4)));
typedef float f32x4 __attribute__((ext_vector_type(4)));
typedef short bf16x8 __attribute__((ext_vector_type(8)));
typedef GAS unsigned gu32;
typedef GAS unsigned long long gu64;
#define RLX_AGENT __ATOMIC_RELAXED, __HIP_MEMORY_SCOPE_AGENT
#define LDS_WAIT() asm volatile("s_waitcnt lgkmcnt(0)" ::: "memory")
#define VM_WAIT() asm volatile("s_waitcnt vmcnt(0)" ::: "memory")
__device__ __forceinline__ unsigned long long rt() { return __builtin_amdgcn_s_memrealtime(); }
__device__ __forceinline__ unsigned f2bf(float f) { unsigned u = __builtin_bit_cast(unsigned, f); return (u + 0x7fffu + ((u >> 16) & 1u)) >> 16; }
__device__ __forceinline__ unsigned pk2(float lo, float hi) { return f2bf(lo) | (f2bf(hi) << 16); }

#define XB_TMO      128
#define XB_XCNT(j)  (256  + 64 * (j))
#define XB_XSUB(j)  (1280 + 64 * (j))
#define XB_XGEN(j)  (2304 + 64 * (j))
#define XB_TOP      3328
#define XB_TOPGEN   3392
#define XCD_BAR_WORDS 3456
#define XB_SPIN_CAP (1u << 18)

__device__ __forceinline__ unsigned xb_ld(unsigned* p)              { return __hip_atomic_load(p, __ATOMIC_RELAXED, __HIP_MEMORY_SCOPE_AGENT); }
__device__ __forceinline__ unsigned xb_add(unsigned* p, unsigned v) { return __hip_atomic_fetch_add(p, v, __ATOMIC_RELAXED, __HIP_MEMORY_SCOPE_AGENT); }
__device__ __forceinline__ unsigned xb_xcc_id() { return (unsigned)__builtin_amdgcn_s_getreg((3 << 11) | 20) & 0xFu; }
#define XB_SPIN(cond, bar) do { unsigned _sp = 0; while (cond) { __builtin_amdgcn_s_sleep(1); \
    if ((++_sp & 255u) == 0u) { if (xb_ld(&(bar)[XB_TMO])) break; if (_sp > XB_SPIN_CAP) { atomicAdd(&(bar)[XB_TMO], 1u); break; } } } } while (0)

struct XcdBarrier {
    unsigned* bar; unsigned x;
    volatile LAS unsigned* st;
};

__device__ __forceinline__ XcdBarrier xcd_barrier_post(unsigned* bar, volatile LAS unsigned* st) {
    XcdBarrier b; b.bar = bar; b.x = xb_xcc_id(); b.st = st;
    if (threadIdx.x == 0) (void)xb_add(&bar[XB_XCNT(b.x)], 1u);
    return b;
}
__device__ __forceinline__ void xcd_barrier_complete(unsigned* bar, unsigned x, unsigned& nloc, unsigned& nx) {
    const unsigned G = gridDim.x * gridDim.y * gridDim.z;
    unsigned sum, cnt, mine, sp = 0u;
    for (;;) {
        sum = 0u; cnt = 0u; mine = 0u;
#pragma unroll
        for (unsigned j = 0; j < 16; ++j) { const unsigned c = xb_ld(&bar[XB_XCNT(j)]); sum += c; cnt += (c > 0u) ? 1u : 0u; mine = (j == x) ? c : mine; }
        if (sum == G) break;
        __builtin_amdgcn_s_sleep(1);
        if ((++sp & 255u) == 0u) { if (xb_ld(&bar[XB_TMO])) break; if (sp > XB_SPIN_CAP) { atomicAdd(&bar[XB_TMO], 1u); break; } }
    }
    nloc = mine > 0u ? mine : 1u; nx = cnt > 0u ? cnt : 1u;
}

__device__ __forceinline__ void xcd_barrier(const XcdBarrier& b) {
    asm volatile("s_waitcnt vmcnt(0)" ::: "memory");
    __syncthreads();
    if (threadIdx.x == 0) {
        unsigned* bar = b.bar;
        __builtin_amdgcn_s_waitcnt(0);
        unsigned nloc = b.st[0], nx = b.st[1];
        if (nloc == 0u) { xcd_barrier_complete(bar, b.x, nloc, nx); b.st[0] = nloc; b.st[1] = nx; }
        const unsigned old = xb_add(&bar[XB_XSUB(b.x)], 1u);
        const unsigned gen = old / nloc;
        if (old + 1u == (gen + 1u) * nloc) {
            __builtin_amdgcn_fence(__ATOMIC_RELEASE, "agent");
            asm volatile("s_waitcnt vmcnt(0)" ::: "memory");
            const unsigned og = xb_add(&bar[XB_TOP], 1u);
            const unsigned tg = og / nx;
            if (og + 1u == (tg + 1u) * nx) xb_add(&bar[XB_TOPGEN], 1u);
            else XB_SPIN(xb_ld(&bar[XB_TOPGEN]) == tg, bar);
            __builtin_amdgcn_fence(__ATOMIC_ACQUIRE, "agent");
            xb_add(&bar[XB_XGEN(b.x)], 1u);
            asm volatile("s_waitcnt vmcnt(0)" ::: "memory");
        } else {
            XB_SPIN(xb_ld(&bar[XB_XGEN(b.x)]) == gen, bar);
            __builtin_amdgcn_fence(__ATOMIC_ACQUIRE, "agent");
            asm volatile("s_waitcnt vmcnt(0)" ::: "memory");
        }
    }
    __syncthreads();
}

constexpr int NWAVES = 8;
constexpr int DM = 1024, NB = 4, SEQ = 4096, MP = NB * SEQ, DB = 128, DT = 4, MS = DB * DT, MA = MP + MS;
constexpr int NIN = 2560, NUP = 5632, DFF = 2816, NADA = 6144, PAST = 2048;
constexpr float EPS = 1e-6f, LAM0 = 0.2f;
constexpr float C2 = attn_body::C2;
static_assert(MP == pg8::MPROMPT, "row split");
constexpr size_t O_YP = 0, O_YS = 16777216, O_KP = 17301504, O_VP = 25690112, O_LCP = 34078720, O_LHP = 34084864, O_FCP = 34086912,
                 O_KS = 34131968, O_VS = 34394112, O_LCS = 34656256, O_LHS = 34852864, O_FCS = 34918400, O_END = 36360192;
constexpr size_t MiB = 1u << 20;
constexpr size_t WS_CTL = 0, CTL_ZERO_BYTES = 1 * MiB;
constexpr size_t WS_WADA = 2 * MiB, WS_WIN = 14 * MiB, WS_WOUT = 19 * MiB, WS_WUP = 21 * MiB, WS_WDN = 32 * MiB;
constexpr size_t WS_SC = 38 * MiB, WS_MOD = 39 * MiB, WS_ROPE = 45 * MiB, WS_SEGA = 46 * MiB, WS_SEGB = 46 * MiB + 512 * 1024;
constexpr size_t WS_XN = 48 * MiB, WS_PROJ = 81 * MiB, WS_QB = 164 * MiB, WS_KB = 181 * MiB, WS_OB = 198 * MiB, WS_HL = 230 * MiB, WS_CA = 247 * MiB;
constexpr size_t WS_MIX = 264 * MiB, WS_X1 = 297 * MiB, WS_UP = 363 * MiB, WS_ACT = 545 * MiB, WS_END = 636 * MiB;
constexpr int CW_BAR = 4096, CW_Q = 8192;

constexpr int RING_OFF = 0, RING_BYTES = 131072, EXTRA_BYTES = 1024;
constexpr int LDSCTL_OFF = RING_BYTES + EXTRA_BYTES, MISC_OFF = LDSCTL_OFF + 320;
constexpr int LDS_BYTES = 147456;
static_assert(MISC_OFF + 128 <= LDS_BYTES, "LDS map");

typedef unsigned u32x2v __attribute__((ext_vector_type(2)));
typedef float f32x2v __attribute__((ext_vector_type(2)));

typedef const unsigned long long __attribute__((address_space(4)))* KIN;
struct Frame {
    LAS unsigned char* lds;
    volatile LAS unsigned* MISC;
    gu32* ctl;
    int tid, lane, wave, vcu, G;
    KIN kin; unsigned char* ws; float* out;
    __device__ __forceinline__ const float* inp(int k) const { return (const float*)(const GAS float*)kin[k]; }
};

__device__ __forceinline__ float wave_sum(float v) {
#pragma unroll
    for (int o = 1; o < 64; o <<= 1) v += __shfl_xor(v, o);
    return v;
}
__device__ __forceinline__ float bflo(unsigned w) { return __uint_as_float(w << 16); }
__device__ __forceinline__ float bfhi(unsigned w) { return __uint_as_float(w & 0xffff0000u); }
__device__ __forceinline__ void unpack8(const v4u r, float (&f)[8]) {
    f[0] = bflo(r.x); f[1] = bfhi(r.x); f[2] = bflo(r.y); f[3] = bfhi(r.y); f[4] = bflo(r.z); f[5] = bfhi(r.z); f[6] = bflo(r.w); f[7] = bfhi(r.w);
}
__device__ __forceinline__ v4u pack8(const float (&f)[8]) {
    v4u o; o.x = pg8::cvt_pk_bf16(f[0], f[1]); o.y = pg8::cvt_pk_bf16(f[2], f[3]); o.z = pg8::cvt_pk_bf16(f[4], f[5]); o.w = pg8::cvt_pk_bf16(f[6], f[7]); return o;
}
__device__ __forceinline__ float sigmoidf_(float x) { return 1.0f / (1.0f + __expf(-x)); }
__device__ __forceinline__ float gelu_tanh(float x) {
    const float u = 0.7978845608028654f * (x + 0.044715f * x * x * x);
    const float t = 1.0f - 2.0f / (1.0f + __expf(2.0f * u));
    return 0.5f * x * (1.0f + t);
}
__device__ __forceinline__ int mod_row(int m) { return (m < MP) ? (m >> 12) : 4 + ((m - MP) >> 2); }

__device__ __forceinline__ void p0_transpose_item(const float* W, int K, int N, bf16* WT, int row_off, LAS float* scr, int item, int lane) {
    const int nblk = N / 32, kb = item / nblk, nb = item % nblk, k0 = 64 * kb, n0 = 32 * nb;
#pragma unroll 8
    for (int i = 0; i < 32; ++i) { const int kk = 2 * i + (lane >> 5); scr[kk * 33 + (lane & 31)] = W[(size_t)(k0 + kk) * N + n0 + (lane & 31)]; }
    LDS_WAIT(); asm volatile("" ::: "memory");
    const int c = lane & 7;
#pragma unroll
    for (int j = 0; j < 4; ++j) { const int n = (lane >> 3) + 8 * j; const LAS float* s = scr + (8 * c) * 33 + n;
        v4u o; o.x = pk2(s[0 * 33], s[1 * 33]); o.y = pk2(s[2 * 33], s[3 * 33]); o.z = pk2(s[4 * 33], s[5 * 33]); o.w = pk2(s[6 * 33], s[7 * 33]);
        *(GAS v4u*)(WT + (size_t)(row_off + n0 + n) * K + k0 + 8 * c) = o; }
    LDS_WAIT(); asm volatile("" ::: "memory");
}
__device__ __forceinline__ void p0_prologue(Frame& F) {
    LAS float* scr = (LAS float*)(F.lds + RING_OFF + F.wave * 16384);
    const int gw = F.vcu * NWAVES + F.wave, NGW = F.G * NWAVES;
    constexpr int I_ADA = (DM / 64) * (NADA / 32), I_IN = (DM / 64) * (NIN / 32), I_OUT = (DM / 64) * (DM / 32), I_UP = (DM / 64) * (NUP / 32), I_DN = (DFF / 64) * (DM / 32);
    constexpr int NITEMS = I_ADA + I_IN + I_OUT + I_UP + I_DN;
    for (int it = gw; it < NITEMS; it += NGW) {
        int r = it;
        if (r < I_ADA) { p0_transpose_item(F.inp(12), DM, NADA, ((bf16*)(F.ws + WS_WADA)), 0, scr, r, F.lane); continue; } r -= I_ADA;
        if (r < I_IN) { p0_transpose_item(F.inp(14), DM, NIN, ((bf16*)(F.ws + WS_WIN)), 0, scr, r, F.lane); continue; } r -= I_IN;
        if (r < I_OUT) { p0_transpose_item(F.inp(22), DM, DM, ((bf16*)(F.ws + WS_WOUT)), 0, scr, r, F.lane); continue; } r -= I_OUT;
        if (r < I_UP) { p0_transpose_item(F.inp(30), DM, NUP, ((bf16*)(F.ws + WS_WUP)), 0, scr, r, F.lane); continue; } r -= I_UP;
        p0_transpose_item(F.inp(33), DFF, DM, ((bf16*)(F.ws + WS_WDN)), 0, scr, r, F.lane);
    }
    for (int r = gw; r < 256; r += NGW) {
        const float* src = (r < 4) ? F.inp(8) + (size_t)r * DM : F.inp(9) + (size_t)(r < 132 ? r - 4 : 0) * DM;
#pragma unroll
        for (int j = 0; j < 4; ++j) { const int c = 4 * F.lane + 256 * j; f32x4 v = *(const f32x4*)(src + c);
            if (r >= 132) v = (f32x4){0.f, 0.f, 0.f, 0.f};
            f32x4 s; s.x = v.x / (1.0f + __expf(-v.x)); s.y = v.y / (1.0f + __expf(-v.y)); s.z = v.z / (1.0f + __expf(-v.z)); s.w = v.w / (1.0f + __expf(-v.w));
            u32x2v o; o.x = pk2(s.x, s.y); o.y = pk2(s.z, s.w); *(u32x2v*)(((bf16*)(F.ws + WS_SC)) + (size_t)r * DM + c) = o; }
    }
    for (int e = gw * 64 + F.lane; e < SEQ * 8; e += NGW * 64) {
        const int pos = e >> 3, j = e & 7;
        const float freq = powf(500000.0f, -(float)j * 0.125f);
        const float ang = (float)pos * freq;
        ((float*)(F.ws + WS_ROPE))[2 * e] = cosf(ang); ((float*)(F.ws + WS_ROPE))[2 * e + 1] = sinf(ang);
    }
}

__device__ __forceinline__ void norm_mod_rows(Frame& F, const float* bp, const float* bs, const float* gn, int sc_off, int sh_off) {
    const int gw = F.vcu * NWAVES + F.wave, NGW = F.G * NWAVES;
    for (int mb = gw; mb < MA; mb += 2 * NGW) {
        const int m2 = mb + NGW; const bool has2 = (m2 < MA); const int mm[2] = {mb, has2 ? m2 : mb};
        f32x4 v[2][4]; float ss[2] = {0.f, 0.f};
#pragma unroll
        for (int r = 0; r < 2; ++r) { const int m = mm[r]; const float* xr = (m < MP) ? bp + (size_t)m * DM : bs + (size_t)(m - MP) * DM;
#pragma unroll
            for (int j = 0; j < 4; ++j) v[r][j] = *(const f32x4*)(xr + 4 * F.lane + 256 * j); }
#pragma unroll
        for (int r = 0; r < 2; ++r)
#pragma unroll
            for (int j = 0; j < 4; ++j) ss[r] += (v[r][j].x * v[r][j].x + v[r][j].y * v[r][j].y) + (v[r][j].z * v[r][j].z + v[r][j].w * v[r][j].w);
#pragma unroll
        for (int r = 0; r < 2; ++r) { if (r == 1 && !has2) break;
            const int m = mm[r]; const float* md = ((float*)(F.ws + WS_MOD)) + (size_t)mod_row(m) * NADA;
            const float rstd = rsqrtf(wave_sum(ss[r]) * (1.0f / DM) + EPS);
#pragma unroll
            for (int j = 0; j < 4; ++j) { const int c = 4 * F.lane + 256 * j;
                const f32x4 g = *(const f32x4*)(gn + c), sc = *(const f32x4*)(md + sc_off + c), sh = *(const f32x4*)(md + sh_off + c);
                const f32x4 o = v[r][j] * rstd * g * (sc + 1.0f) + sh;
                u32x2v w; w.x = pg8::cvt_pk_bf16(o.x, o.y); w.y = pg8::cvt_pk_bf16(o.z, o.w); *(u32x2v*)(((bf16*)(F.ws + WS_XN)) + (size_t)m * DM + c) = w; } }
    }
}

__device__ __forceinline__ void p4_tile(Frame& F, int m0, int nrows, const bf16x8 (&Bf)[2][2][4], const float (&brg)[4], const float (&big)[4], const float (&spl)[4]) {
    const int lane = F.lane, w = F.wave;
    const bool samp = (m0 >= MP);
    {
        const int d0 = (8 * lane) & 63, l8 = lane & 7;
        float gq[8], gk[8];
        { const f32x4 a = *(const f32x4*)(F.inp(15) + d0), b = *(const f32x4*)(F.inp(15) + d0 + 4), c = *(const f32x4*)(F.inp(16) + d0), d = *(const f32x4*)(F.inp(16) + d0 + 4);
          gq[0] = a.x; gq[1] = a.y; gq[2] = a.z; gq[3] = a.w; gq[4] = b.x; gq[5] = b.y; gq[6] = b.z; gq[7] = b.w;
          gk[0] = c.x; gk[1] = c.y; gk[2] = c.z; gk[3] = c.w; gk[4] = d.x; gk[5] = d.y; gk[6] = d.z; gk[7] = d.w; }
        const int rpw = nrows >> 3;
#pragma unroll 2
        for (int rr = 0; rr < rpw; ++rr) {
            const int m = m0 + w * rpw + rr;
            const int tt = samp ? ((m - MP) & 3) : (m & (SEQ - 1));
            const int pos = samp ? PAST + tt : tt;
            const bf16* prow = ((bf16*)(F.ws + WS_PROJ)) + (size_t)m * NIN;
            const v4u qraw = *(const v4u*)(prow + 8 * lane), kraw = *(const v4u*)(prow + 512 + 8 * lane), vraw = *(const v4u*)(prow + 1024 + 8 * lane);
            float q[8], k[8], v[8]; unpack8(qraw, q); unpack8(kraw, k); unpack8(vraw, v);
            float sq = 0.f, sk = 0.f;
#pragma unroll
            for (int j = 0; j < 8; ++j) { sq += q[j] * q[j]; sk += k[j] * k[j]; }
            sq += __shfl_xor(sq, 1); sk += __shfl_xor(sk, 1); sq += __shfl_xor(sq, 2); sk += __shfl_xor(sk, 2); sq += __shfl_xor(sq, 4); sk += __shfl_xor(sk, 4);
            const float rq = rsqrtf(sq * (1.0f / 64.0f) + EPS), rk = rsqrtf(sk * (1.0f / 64.0f) + EPS);
#pragma unroll
            for (int j = 0; j < 8; ++j) { q[j] *= rq * gq[j]; k[j] *= rk * gk[j]; }
            const float* rp = ((float*)(F.ws + WS_ROPE)) + (size_t)pos * 16;
            const f32x4 t0 = *(const f32x4*)(rp), t1 = *(const f32x4*)(rp + 4), t2 = *(const f32x4*)(rp + 8), t3 = *(const f32x4*)(rp + 12);
            const float cs[8] = {t0.x, t0.z, t1.x, t1.z, t2.x, t2.z, t3.x, t3.z}, sn[8] = {t0.y, t0.w, t1.y, t1.w, t2.y, t2.w, t3.y, t3.w};
#pragma unroll
            for (int j = 0; j < 8; ++j) { const float pq = __shfl_xor(q[j], 1), pk = __shfl_xor(k[j], 1);
                if (l8 == 0) { q[j] = q[j] * cs[j] - pq * sn[j]; k[j] = k[j] * cs[j] - pk * sn[j]; }
                else if (l8 == 1) { q[j] = pq * sn[j] + q[j] * cs[j]; k[j] = pk * sn[j] + k[j] * cs[j]; } }
            float* kout = samp ? F.out + O_KS + (size_t)(m - MP) * 512 + 8 * lane : F.out + O_KP + (size_t)m * 512 + 8 * lane;
            float* vout = samp ? F.out + O_VS + (size_t)(m - MP) * 512 + 8 * lane : F.out + O_VP + (size_t)m * 512 + 8 * lane;
            *(f32x4*)kout = (f32x4){k[0], k[1], k[2], k[3]}; *(f32x4*)(kout + 4) = (f32x4){k[4], k[5], k[6], k[7]};
            *(f32x4*)vout = (f32x4){v[0], v[1], v[2], v[3]}; *(f32x4*)(vout + 4) = (f32x4){v[4], v[5], v[6], v[7]};
            *(v4u*)(((bf16*)(F.ws + WS_KB)) + (size_t)m * 512 + 8 * lane) = pack8(k);
#pragma unroll
            for (int j = 0; j < 8; ++j) q[j] *= C2;
            *(v4u*)(((bf16*)(F.ws + WS_QB)) + (size_t)m * 512 + 8 * lane) = pack8(q);
            const int kk = samp ? tt - 1 : tt - (SEQ - 3);
            if (kk >= 0) {
                const v4u lraw = *(const v4u*)(prow + 1536 + 8 * lane); float lx[8]; unpack8(lraw, lx);
                float* lo = samp ? F.out + O_LCS + ((size_t)((m - MP) >> 2) * 3 + kk) * 512 + 8 * lane : F.out + O_LCP + ((size_t)(m >> 12) * 3 + kk) * 512 + 8 * lane;
                *(f32x4*)lo = (f32x4){lx[0], lx[1], lx[2], lx[3]}; *(f32x4*)(lo + 4) = (f32x4){lx[4], lx[5], lx[6], lx[7]};
            }
        }
    }
    {
        LAS float* XC = (LAS float*)(F.lds + RING_OFF + w * 8704);
        LAS float* LA = XC + 16 * 68;
        const int ch0 = w * 64, c8 = lane & 7, tr = lane >> 3, fr = lane & 15, fq = lane >> 4;
        float cw[4][8], cb[8];
#pragma unroll
        for (int k = 0; k < 4; ++k) { const f32x4 a = *(const f32x4*)(F.inp(23) + k * 512 + ch0 + 8 * c8), b = *(const f32x4*)(F.inp(23) + k * 512 + ch0 + 8 * c8 + 4);
            cw[k][0] = a.x; cw[k][1] = a.y; cw[k][2] = a.z; cw[k][3] = a.w; cw[k][4] = b.x; cw[k][5] = b.y; cw[k][6] = b.z; cw[k][7] = b.w; }
        { const f32x4 a = *(const f32x4*)(F.inp(24) + ch0 + 8 * c8), b = *(const f32x4*)(F.inp(24) + ch0 + 8 * c8 + 4);
          cb[0] = a.x; cb[1] = a.y; cb[2] = a.z; cb[3] = a.w; cb[4] = b.x; cb[5] = b.y; cb[6] = b.z; cb[7] = b.w; }
        float hA = 1.0f, hB = 0.0f;
        const int nsub = nrows >> 4;
        for (int sub = 0; sub < nsub; ++sub) {
            const int mt = m0 + 16 * sub;
#pragma unroll
            for (int i = 0; i < 2; ++i) {
                const int tok = tr + 8 * i, m = mt + tok;
                const int tt = samp ? ((m - MP) & 3) : (m & (SEQ - 1));
                float acc[8];
#pragma unroll
                for (int j = 0; j < 8; ++j) acc[j] = cb[j];
#pragma unroll
                for (int kk = 0; kk < 4; ++kk) {
                    float lx[8];
                    if (tt - kk >= 0) { const v4u r = *(const v4u*)(((bf16*)(F.ws + WS_PROJ)) + (size_t)(m - kk) * NIN + 1536 + ch0 + 8 * c8); unpack8(r, lx); }
                    else if (samp) { const float* sp = F.inp(5) + ((size_t)((m - MP) >> 2) * 3 + (tt - kk + 3)) * 512 + ch0 + 8 * c8;
                        const f32x4 a = *(const f32x4*)sp, b = *(const f32x4*)(sp + 4); lx[0] = a.x; lx[1] = a.y; lx[2] = a.z; lx[3] = a.w; lx[4] = b.x; lx[5] = b.y; lx[6] = b.z; lx[7] = b.w; }
                    else {
#pragma unroll
                        for (int j = 0; j < 8; ++j) lx[j] = 0.f; }
#pragma unroll
                    for (int j = 0; j < 8; ++j) acc[j] += cw[3 - kk][j] * lx[j];
                }
                *(LAS f32x4*)(XC + tok * 68 + 8 * c8) = (f32x4){acc[0], acc[1], acc[2], acc[3]};
                *(LAS f32x4*)(XC + tok * 68 + 8 * c8 + 4) = (f32x4){acc[4], acc[5], acc[6], acc[7]};
            }
            LDS_WAIT(); asm volatile("" ::: "memory");
            f32x4 Dr[4], Di[4];
#pragma unroll
            for (int ct = 0; ct < 4; ++ct) { Dr[ct] = (f32x4){0.f, 0.f, 0.f, 0.f}; Di[ct] = (f32x4){0.f, 0.f, 0.f, 0.f}; }
#pragma unroll
            for (int s = 0; s < 2; ++s) {
                const LAS float* ap = XC + fr * 68 + 32 * s + 8 * fq;
                const f32x4 a0 = *(const LAS f32x4*)ap, a1 = *(const LAS f32x4*)(ap + 4);
                v4u aw; aw.x = pg8::cvt_pk_bf16(a0.x, a0.y); aw.y = pg8::cvt_pk_bf16(a0.z, a0.w); aw.z = pg8::cvt_pk_bf16(a1.x, a1.y); aw.w = pg8::cvt_pk_bf16(a1.z, a1.w);
                const bf16x8 af = __builtin_bit_cast(bf16x8, aw);
#pragma unroll
                for (int ct = 0; ct < 4; ++ct) { Dr[ct] = __builtin_amdgcn_mfma_f32_16x16x32_bf16(af, Bf[0][s][ct], Dr[ct], 0, 0, 0); Di[ct] = __builtin_amdgcn_mfma_f32_16x16x32_bf16(af, Bf[1][s][ct], Di[ct], 0, 0, 0); }
            }
#pragma unroll
            for (int ct = 0; ct < 4; ++ct)
#pragma unroll
                for (int i = 0; i < 4; ++i) { const int o = (4 * fq + i) * 68 + 16 * ct + fr;
                    const float xcv = XC[o], r = sigmoidf_(Dr[ct][i] + brg[ct]), ig = sigmoidf_(Di[ct][i] + big[ct]);
                    const float la = -8.0f * r * spl[ct], a = __expf(la), x2 = 2.0f * la;
                    const float em = (x2 > -0.1f) ? x2 * (1.0f + x2 * (0.5f + x2 * (0.16666667f + x2 * 0.041666668f))) : __expf(x2) - 1.0f;
                    LA[o] = a; XC[o] = sqrtf(-em) * ig * xcv; }
            LDS_WAIT(); asm volatile("" ::: "memory");
#pragma unroll
            for (int tok = 0; tok < 16; ++tok) {
                if (samp && (tok & 3) == 0) { hB = F.inp(6)[(size_t)((mt + tok - MP) >> 2) * 512 + ch0 + lane]; hA = 1.0f; }
                const float a = LA[tok * 68 + lane], bb = XC[tok * 68 + lane];
                hB = a * hB + bb; hA *= a; XC[tok * 68 + lane] = hB; LA[tok * 68 + lane] = hA;
            }
            LDS_WAIT(); asm volatile("" ::: "memory");
#pragma unroll
            for (int i = 0; i < 2; ++i) { const int tok = tr + 8 * i; const size_t go = (size_t)(mt + tok) * 512 + ch0 + 8 * c8;
                const f32x4 h0 = *(const LAS f32x4*)(XC + tok * 68 + 8 * c8), h1 = *(const LAS f32x4*)(XC + tok * 68 + 8 * c8 + 4);
                const f32x4 a0 = *(const LAS f32x4*)(LA + tok * 68 + 8 * c8), a1 = *(const LAS f32x4*)(LA + tok * 68 + 8 * c8 + 4);
                v4u hw, awv; hw.x = pg8::cvt_pk_bf16(h0.x, h0.y); hw.y = pg8::cvt_pk_bf16(h0.z, h0.w); hw.z = pg8::cvt_pk_bf16(h1.x, h1.y); hw.w = pg8::cvt_pk_bf16(h1.z, h1.w);
                awv.x = pg8::cvt_pk_bf16(a0.x, a0.y); awv.y = pg8::cvt_pk_bf16(a0.z, a0.w); awv.z = pg8::cvt_pk_bf16(a1.x, a1.y); awv.w = pg8::cvt_pk_bf16(a1.z, a1.w);
                *(v4u*)(((bf16*)(F.ws + WS_HL)) + go) = hw; *(v4u*)(((bf16*)(F.ws + WS_CA)) + go) = awv; }
            LDS_WAIT(); asm volatile("" ::: "memory");
        }
        if (!samp) { const size_t so = ((size_t)(m0 >> 12) * 64 + ((m0 & (SEQ - 1)) >> 6)) * 512 + ch0 + lane; ((float*)(F.ws + WS_SEGA))[so] = hA; ((float*)(F.ws + WS_SEGB))[so] = hB; }
    }
}
__device__ __forceinline__ void p4_phase(Frame& F) {
    const int lane = F.lane, w = F.wave, fr = lane & 15, fq = lane >> 4;
    bf16x8 Bf[2][2][4];
#pragma unroll
    for (int gt = 0; gt < 2; ++gt) { const float* W = (gt == 0 ? F.inp(25) : F.inp(27)) + (size_t)w * 4096;
#pragma unroll
        for (int s = 0; s < 2; ++s)
#pragma unroll
            for (int ct = 0; ct < 4; ++ct) { float e[8];
#pragma unroll
                for (int j = 0; j < 8; ++j) e[j] = W[(32 * s + 8 * fq + j) * 64 + 16 * ct + fr];
                Bf[gt][s][ct] = __builtin_bit_cast(bf16x8, pack8(e)); } }
    float brg[4], big[4], spl[4];
#pragma unroll
    for (int ct = 0; ct < 4; ++ct) { const int ch = w * 64 + 16 * ct + fr; brg[ct] = F.inp(26)[ch]; big[ct] = F.inp(28)[ch]; spl[ct] = log1pf(__expf(-F.inp(29)[ch])); }
    { int tp = F.vcu, tq = F.G - 1 - F.vcu;
      for (;;) { int m0, nrows; if (tp < 256) { m0 = 64 * tp; nrows = 64; tp += F.G; } else if (tq < 32) { m0 = MP + 16 * tq; nrows = 16; tq += F.G; } else break;
          p4_tile(F, m0, nrows, Bf, brg, big, spl); } }
}

template <int CTRL> __device__ __forceinline__ float dppf(float x) { return __builtin_bit_cast(float, __builtin_amdgcn_mov_dpp(__builtin_bit_cast(int, x), CTRL, 0xf, 0xf, true)); }
constexpr int DPP_XOR1 = 0xB1, DPP_XOR2 = 0x4E, DPP_XOR7 = 0x141, DPP_ROR8 = 0x128, DPP_ROR4 = 0x124;
__device__ __forceinline__ float sa_group(const f32x4& k0, const f32x4& k1, const f32x4& k2, const f32x4& k3, const f32x2v (&qp)[2][4], int l16) {
    float v[16];
#pragma unroll
    for (int pr = 0; pr < 2; ++pr) {
        f32x2v a0 = qp[pr][0] * k0.x, a1 = qp[pr][0] * k1.x, a2 = qp[pr][0] * k2.x, a3 = qp[pr][0] * k3.x;
        a0 = qp[pr][1] * k0.y + a0; a1 = qp[pr][1] * k1.y + a1; a2 = qp[pr][1] * k2.y + a2; a3 = qp[pr][1] * k3.y + a3;
        a0 = qp[pr][2] * k0.z + a0; a1 = qp[pr][2] * k1.z + a1; a2 = qp[pr][2] * k2.z + a2; a3 = qp[pr][2] * k3.z + a3;
        a0 = qp[pr][3] * k0.w + a0; a1 = qp[pr][3] * k1.w + a1; a2 = qp[pr][3] * k2.w + a2; a3 = qp[pr][3] * k3.w + a3;
        v[0 + 2 * pr] = a0.x; v[1 + 2 * pr] = a0.y; v[4 + 2 * pr] = a1.x; v[5 + 2 * pr] = a1.y; v[8 + 2 * pr] = a2.x; v[9 + 2 * pr] = a2.y; v[12 + 2 * pr] = a3.x; v[13 + 2 * pr] = a3.y;
    }
    const bool b3 = (l16 & 8) != 0, b2 = (l16 & 4) != 0, b1 = (l16 & 2) != 0, b0 = (l16 & 1) != 0;
#pragma unroll
    for (int a = 0; a < 8; ++a) { const float keep = b3 ? v[a + 8] : v[a], send = b3 ? v[a] : v[a + 8]; v[a] = keep + dppf<DPP_ROR8>(send); }
#pragma unroll
    for (int a = 0; a < 4; ++a) { const float keep = b2 ? v[a + 4] : v[a], send = b2 ? v[a] : v[a + 4]; v[a] = keep + dppf<DPP_XOR7>(send); }
#pragma unroll
    for (int a = 0; a < 2; ++a) { const float keep = b1 ? v[a + 2] : v[a], send = b1 ? v[a] : v[a + 2]; v[a] = keep + dppf<DPP_XOR2>(send); }
    const float keep = b0 ? v[1] : v[0], send = b0 ? v[0] : v[1];
    return keep + dppf<DPP_XOR1>(send);
}
__device__ __forceinline__ f32x4 ntload4(const float* p) { return __builtin_nontemporal_load((const f32x4*)p); }
__device__ __forceinline__ void sattn_unit(Frame& F, int s, int hp, float lam) {
    const int lane = F.lane, w = F.wave, l16 = lane & 15, grp = lane >> 4;
    LAS float* SB = (LAS float*)(F.lds + RING_OFF) + w * 4096;
    const int mrow0 = MP + s * 4;
    const int qcol = (2 * hp + (grp >> 1)) * 128 + (grp & 1) * 64 + 4 * l16;
    f32x2v qp[2][4];
    { float q[4][4];
#pragma unroll
      for (int qi = 0; qi < 4; ++qi) { const u32x2v r = *(const u32x2v*)(((bf16*)(F.ws + WS_QB)) + (size_t)(mrow0 + qi) * 512 + qcol); q[qi][0] = bflo(r.x); q[qi][1] = bfhi(r.x); q[qi][2] = bflo(r.y); q[qi][3] = bfhi(r.y); }
#pragma unroll
      for (int pr = 0; pr < 2; ++pr)
#pragma unroll
          for (int e = 0; e < 4; ++e) qp[pr][e] = (f32x2v){q[2 * pr][e], q[2 * pr + 1][e]}; }
    const int* ptab = ((const int*)(const GAS int*)F.kin[4]) + s * 16 + 2 * w;
    const int pg0 = __builtin_amdgcn_readfirstlane(ptab[0]), pg1 = __builtin_amdgcn_readfirstlane(ptab[1]);
    const int ridx = (l16 >> 2) * 16 + grp * 4 + (l16 & 3);
    float mx = -INFINITY;
    {
        const __amdgpu_buffer_rsrc_t rk = __builtin_amdgcn_make_buffer_rsrc((void*)F.inp(2), 0, 2560 * 128 * 512 * 4, 0x00020000);
        const unsigned kb0 = (unsigned)pg0 * 262144u + (unsigned)hp * 1024u, kb1 = (unsigned)pg1 * 262144u + (unsigned)hp * 1024u;
        const unsigned lane16 = 16u * (unsigned)lane;
        f32x4 kb[6][4];
#define SA_LOADK(B, G) do { const int g_ = (G) < 64 ? (G) : 63, j0_ = 4 * g_; const unsigned so_ = ((j0_ < 128) ? kb0 : kb1) + (unsigned)(j0_ & 127) * 2048u; \
            _Pragma("unroll") for (int i_ = 0; i_ < 4; ++i_) kb[B][i_] = __builtin_bit_cast(f32x4, __builtin_amdgcn_raw_buffer_load_b128(rk, lane16, so_ + (unsigned)i_ * 2048u, 2)); } while (0)
#define SA_STEPK(B, G) do { const float s0_ = sa_group(kb[B][0], kb[B][1], kb[B][2], kb[B][3], qp, l16); \
            SB[(G) * 64 + ridx] = s0_; mx = fmaxf(mx, s0_); __builtin_amdgcn_sched_barrier(0); } while (0)
        SA_LOADK(0, 0); SA_LOADK(1, 1); SA_LOADK(2, 2); SA_LOADK(3, 3); SA_LOADK(4, 4);
#pragma nounroll
        for (int g = 0; g < 60; g += 6) {
            SA_LOADK(5, g + 5);  SA_STEPK(0, g);
            SA_LOADK(0, g + 6);  SA_STEPK(1, g + 1);
            SA_LOADK(1, g + 7);  SA_STEPK(2, g + 2);
            SA_LOADK(2, g + 8);  SA_STEPK(3, g + 3);
            SA_LOADK(3, g + 9);  SA_STEPK(4, g + 4);
            SA_LOADK(4, g + 10); SA_STEPK(5, g + 5);
        }
        SA_STEPK(0, 60); SA_STEPK(1, 61); SA_STEPK(2, 62); SA_STEPK(3, 63);
#undef SA_LOADK
#undef SA_STEPK
    }
    int NG = 64;
    if (w == 7) {
        f32x4 kn[4];
#pragma unroll
        for (int g = 0; g < 4; ++g) { const u32x2v r = *(const u32x2v*)(((bf16*)(F.ws + WS_KB)) + (size_t)(mrow0 + g) * 512 + qcol); kn[g] = (f32x4){bflo(r.x), bfhi(r.x), bflo(r.y), bfhi(r.y)}; }
        float sc = sa_group(kn[0], kn[1], kn[2], kn[3], qp, l16);
        if ((l16 >> 2) > (l16 & 3)) sc = -INFINITY;
        SB[64 * 64 + ridx] = sc; mx = fmaxf(mx, sc); NG = 65;
    }
    mx = fmaxf(mx, dppf<DPP_ROR4>(mx)); mx = fmaxf(mx, dppf<DPP_ROR8>(mx));
    LDS_WAIT(); asm volatile("" ::: "memory");
    float ls = 0.f;
    for (int g = 0; g < NG; ++g) { const float p = __builtin_amdgcn_exp2f(SB[g * 64 + ridx] - mx); ls += p; SB[g * 64 + ridx] = p; }
    ls += dppf<DPP_ROR4>(ls); ls += dppf<DPP_ROR8>(ls);
    LDS_WAIT(); asm volatile("" ::: "memory");
    const int hh = lane >> 5, dv4 = 4 * (lane & 31);
    f32x4 O[8];
#pragma unroll
    for (int r = 0; r < 8; ++r) O[r] = (f32x4){0.f, 0.f, 0.f, 0.f};
    {
        const __amdgpu_buffer_rsrc_t rv = __builtin_amdgcn_make_buffer_rsrc((void*)F.inp(3), 0, 2560 * 128 * 512 * 4, 0x00020000);
        const unsigned vb0 = (unsigned)pg0 * 262144u + (unsigned)hp * 1024u, vb1 = (unsigned)pg1 * 262144u + (unsigned)hp * 1024u;
        const unsigned lane16 = 16u * (unsigned)lane;
        f32x4 vb[6][4];
#define SA_LOADV(B, G) do { const int g_ = (G) < 64 ? (G) : 63, j0_ = 4 * g_; const unsigned so_ = ((j0_ < 128) ? vb0 : vb1) + (unsigned)(j0_ & 127) * 2048u; \
            _Pragma("unroll") for (int i_ = 0; i_ < 4; ++i_) vb[B][i_] = __builtin_bit_cast(f32x4, __builtin_amdgcn_raw_buffer_load_b128(rv, lane16, so_ + (unsigned)i_ * 2048u, 2)); } while (0)
#define SA_STEPV(B, G) do { _Pragma("unroll") for (int i_ = 0; i_ < 4; ++i_) { const LAS f32x4* pp_ = (const LAS f32x4*)(SB + (4 * (G) + i_) * 16 + hh * 8); const f32x4 p0_ = pp_[0], p1_ = pp_[1]; \
            _Pragma("unroll") for (int r_ = 0; r_ < 4; ++r_) { O[r_] += vb[B][i_] * p0_[r_]; O[4 + r_] += vb[B][i_] * p1_[r_]; } } __builtin_amdgcn_sched_barrier(0); } while (0)
        SA_LOADV(0, 0); SA_LOADV(1, 1); SA_LOADV(2, 2); SA_LOADV(3, 3); SA_LOADV(4, 4);
#pragma nounroll
        for (int g = 0; g < 60; g += 6) {
            SA_LOADV(5, g + 5);  SA_STEPV(0, g);
            SA_LOADV(0, g + 6);  SA_STEPV(1, g + 1);
            SA_LOADV(1, g + 7);  SA_STEPV(2, g + 2);
            SA_LOADV(2, g + 8);  SA_STEPV(3, g + 3);
            SA_LOADV(3, g + 9);  SA_STEPV(4, g + 4);
            SA_LOADV(4, g + 10); SA_STEPV(5, g + 5);
        }
        SA_STEPV(0, 60); SA_STEPV(1, 61); SA_STEPV(2, 62); SA_STEPV(3, 63);
#undef SA_LOADV
#undef SA_STEPV
        if (w == 7) {
#pragma unroll
            for (int g = 0; g < 4; ++g) { const u32x2v r = *(const u32x2v*)(((bf16*)(F.ws + WS_PROJ)) + (size_t)(mrow0 + g) * NIN + 1024 + (2 * hp + hh) * 128 + dv4);
                const f32x4 vv = (f32x4){bflo(r.x), bfhi(r.x), bflo(r.y), bfhi(r.y)};
                const LAS f32x4* pp = (const LAS f32x4*)(SB + (256 + g) * 16 + hh * 8); const f32x4 p0 = pp[0], p1 = pp[1];
#pragma unroll
                for (int rr = 0; rr < 4; ++rr) { O[rr] += vv * p0[rr]; O[4 + rr] += vv * p1[rr]; } }
        }
    }
    LDS_WAIT(); __syncthreads();
    LAS float* OW = (LAS float*)(F.lds + RING_OFF);
    LAS float* ML = OW + 8 * 16 * 128;
#pragma unroll
    for (int r = 0; r < 8; ++r) *(LAS f32x4*)(OW + (size_t)((w * 16 + hh * 8 + r) * 128) + dv4) = O[r];
    if (l16 < 4) { const int row16 = grp * 4 + l16; ML[(w * 16 + row16) * 2] = mx; ML[(w * 16 + row16) * 2 + 1] = ls; }
    LDS_WAIT(); __syncthreads();
    {
        const int hh2 = w >> 2, qi = w & 3; float oc[2][2];
#pragma unroll
        for (int c = 0; c < 2; ++c) { const int row16 = hh2 * 8 + c * 4 + qi; float M = -INFINITY;
#pragma unroll
            for (int ww = 0; ww < 8; ++ww) M = fmaxf(M, ML[(ww * 16 + row16) * 2]);
            float L = 0.f, a0 = 0.f, a1 = 0.f;
#pragma unroll
            for (int ww = 0; ww < 8; ++ww) { const float f = __builtin_amdgcn_exp2f(ML[(ww * 16 + row16) * 2] - M); L += f * ML[(ww * 16 + row16) * 2 + 1];
                const f32x2v o = *(const LAS f32x2v*)(OW + (ww * 16 + row16) * 128 + 2 * lane); a0 += f * o.x; a1 += f * o.y; }
            const float inv = 1.0f / L; oc[c][0] = a0 * inv; oc[c][1] = a1 * inv; }
        const float o0 = oc[0][0] - lam * oc[1][0], o1 = oc[0][1] - lam * oc[1][1];
        const float rstd = rsqrtf(wave_sum(o0 * o0 + o1 * o1) * (1.0f / 128.0f) + EPS);
        const float g0 = F.inp(21)[2 * lane], g1 = F.inp(21)[2 * lane + 1];
        *(unsigned*)(((bf16*)(F.ws + WS_MIX)) + (size_t)(mrow0 + qi) * DM + (2 * hp + hh2) * 128 + 2 * lane) = pg8::cvt_pk_bf16(o0 * rstd * g0 * (1.0f - LAM0), o1 * rstd * g1 * (1.0f - LAM0));
    }
    LDS_WAIT(); __syncthreads();
}
__device__ __forceinline__ float diff_lambda(Frame& F) {
    const float a = wave_sum(F.inp(17)[F.lane] * F.inp(18)[F.lane]), b = wave_sum(F.inp(19)[F.lane] * F.inp(20)[F.lane]);
    return __expf(a) - __expf(b) + LAM0;
}


__device__ __forceinline__ int q_pop(Frame& F, int kind, int q, int bank) {
    volatile LAS int* slot = (volatile LAS int*)(F.lds + LDSCTL_OFF);
    if (threadIdx.x == 0) *slot = (int)__hip_atomic_fetch_add((unsigned*)(F.ctl + CW_Q + bank * 1024 + (kind * 8 + q) * 64), 1u, __ATOMIC_RELAXED, __HIP_MEMORY_SCOPE_AGENT);
    __syncthreads();
    const int r = *slot;
    __syncthreads();
    return r;
}

__device__ __forceinline__ void p6_tile(Frame& F, int m0, int nrows, float lam) {
    const int lane = F.lane, w = F.wave;
    const bool samp = (m0 >= MP);
    LAS float* CARRY = (LAS float*)(F.lds + RING_OFF);
    {
        float carry = 0.f;
        if (!samp) { const int b = m0 >> 12, seg = (m0 & (SEQ - 1)) >> 6; const float* pa = ((float*)(F.ws + WS_SEGA)) + (size_t)b * 64 * 512 + F.tid; const float* pb = ((float*)(F.ws + WS_SEGB)) + (size_t)b * 64 * 512 + F.tid;
#pragma unroll 8
            for (int sg = 0; sg < seg; ++sg) carry = pa[(size_t)sg * 512] * carry + pb[(size_t)sg * 512]; }
        CARRY[F.tid] = carry;
    }
    LDS_WAIT(); __syncthreads();
    float cr[8];
    { const f32x4 a = *(const LAS f32x4*)(CARRY + 8 * lane), b = *(const LAS f32x4*)(CARRY + 8 * lane + 4); cr[0] = a.x; cr[1] = a.y; cr[2] = a.z; cr[3] = a.w; cr[4] = b.x; cr[5] = b.y; cr[6] = b.z; cr[7] = b.w; }
    float gs[8];
    { const int dv = 8 * (lane & 15); const f32x4 a = *(const f32x4*)(F.inp(21) + dv), b = *(const f32x4*)(F.inp(21) + dv + 4); gs[0] = a.x; gs[1] = a.y; gs[2] = a.z; gs[3] = a.w; gs[4] = b.x; gs[5] = b.y; gs[6] = b.z; gs[7] = b.w; }
    const int rpw = nrows >> 3;
#pragma unroll 2
    for (int rr = 0; rr < rpw; ++rr) {
        const int m = m0 + w * rpw + rr;
        if (!samp) {
            const bf16* orow = ((bf16*)(F.ws + WS_OB)) + (size_t)m * 1024 + (lane >> 4) * 256 + 8 * (lane & 15);
            const v4u r0 = *(const v4u*)orow, r1 = *(const v4u*)(orow + 128);
            float o0[8], o1[8]; unpack8(r0, o0); unpack8(r1, o1);
            float ss = 0.f;
#pragma unroll
            for (int j = 0; j < 8; ++j) { o0[j] -= lam * o1[j]; ss += o0[j] * o0[j]; }
            ss += __shfl_xor(ss, 1); ss += __shfl_xor(ss, 2); ss += __shfl_xor(ss, 4); ss += __shfl_xor(ss, 8);
            const float rstd = rsqrtf(ss * (1.0f / 128.0f) + EPS) * (1.0f - LAM0);
#pragma unroll
            for (int j = 0; j < 8; ++j) o0[j] *= rstd * gs[j];
            *(v4u*)(((bf16*)(F.ws + WS_MIX)) + (size_t)m * DM + 8 * lane) = pack8(o0);
        }
        {
            const v4u hr = *(const v4u*)(((bf16*)(F.ws + WS_HL)) + (size_t)m * 512 + 8 * lane), ar = *(const v4u*)(((bf16*)(F.ws + WS_CA)) + (size_t)m * 512 + 8 * lane), gr = *(const v4u*)(((bf16*)(F.ws + WS_PROJ)) + (size_t)m * NIN + 2048 + 8 * lane);
            float h[8], a[8], lg[8]; unpack8(hr, h); unpack8(ar, a); unpack8(gr, lg);
#pragma unroll
            for (int j = 0; j < 8; ++j) h[j] += a[j] * cr[j];
            const int tt = samp ? ((m - MP) & 3) : (m & (SEQ - 1));
            if (tt == (samp ? 3 : SEQ - 1)) { float* ho = samp ? F.out + O_LHS + (size_t)((m - MP) >> 2) * 512 + 8 * lane : F.out + O_LHP + (size_t)(m >> 12) * 512 + 8 * lane;
                *(f32x4*)ho = (f32x4){h[0], h[1], h[2], h[3]}; *(f32x4*)(ho + 4) = (f32x4){h[4], h[5], h[6], h[7]}; }
#pragma unroll
            for (int j = 0; j < 8; ++j) h[j] *= gelu_tanh(lg[j]);
            *(v4u*)(((bf16*)(F.ws + WS_MIX)) + (size_t)m * DM + 512 + 8 * lane) = pack8(h);
        }
    }
    LDS_WAIT(); __syncthreads();
}


template <int K> __device__ __forceinline__ void sample_gemm(Frame& F, const bf16* A, const bf16* Bt, const float* bs, const float* gate, float* out) {
    constexpr int KW = K / 8, NS = KW / 32;
    static_assert(KW % 32 == 0, "K/8 must be a multiple of 32");
    const int lane = F.lane, w = F.wave, fr = lane & 15, fq = lane >> 4;
    for (int blk = F.vcu; blk < 256; blk += F.G) {
        const int rb = blk >> 4, cb = blk & 15;
        const bf16* ap = A + (size_t)(MP + 32 * rb + fr) * K + w * KW + 8 * fq;
        const bf16* bp = Bt + (size_t)(64 * cb + fr) * K + w * KW + 8 * fq;
        f32x4 D[2][4];
#pragma unroll
        for (int rt = 0; rt < 2; ++rt)
#pragma unroll
            for (int ct = 0; ct < 4; ++ct) D[rt][ct] = (f32x4){0.f, 0.f, 0.f, 0.f};
#pragma unroll
        for (int s = 0; s < NS; ++s) {
            bf16x8 af[2], bfr[4];
#pragma unroll
            for (int rt = 0; rt < 2; ++rt) af[rt] = *(const bf16x8*)(ap + (size_t)(16 * rt) * K + 32 * s);
#pragma unroll
            for (int ct = 0; ct < 4; ++ct) bfr[ct] = *(const bf16x8*)(bp + (size_t)(16 * ct) * K + 32 * s);
#pragma unroll
            for (int rt = 0; rt < 2; ++rt)
#pragma unroll
                for (int ct = 0; ct < 4; ++ct) D[rt][ct] = __builtin_amdgcn_mfma_f32_16x16x32_bf16(af[rt], bfr[ct], D[rt][ct], 0, 0, 0);
        }
        LAS float* P = (LAS float*)(F.lds + RING_OFF) + w * 2048;
#pragma unroll
        for (int rt = 0; rt < 2; ++rt)
#pragma unroll
            for (int ct = 0; ct < 4; ++ct)
#pragma unroll
                for (int i = 0; i < 4; ++i) P[(16 * rt + 4 * fq + i) * 64 + 16 * ct + fr] = D[rt][ct][i];
        LDS_WAIT(); __syncthreads();
        { const int row = F.tid >> 4, c4 = (F.tid & 15) * 4; f32x4 acc = (f32x4){0.f, 0.f, 0.f, 0.f};
#pragma unroll
          for (int ww = 0; ww < 8; ++ww) acc += *(const LAS f32x4*)((LAS float*)(F.lds + RING_OFF) + ww * 2048 + row * 64 + c4);
          const int r = 32 * rb + row, col = 64 * cb + c4;
          const f32x4 bb = *(const f32x4*)(bs + (size_t)r * DM + col), gg = *(const f32x4*)(gate + (size_t)(4 + (r >> 2)) * NADA + col);
          *(f32x4*)(out + (size_t)(MP + r) * DM + col) = bb + gg * acc; }
        LDS_WAIT(); __syncthreads();
    }
}

__device__ __forceinline__ void p10_phase(Frame& F) {
    const int c = F.tid;
    const bool act = (c < DFF / 8);
    const int cg = act ? 8 * c : 0, cv = DFF + cg;
    float wg[3][8], wv[3][8], bg[8], bv[8];
#pragma unroll
    for (int k = 0; k < 3; ++k) { const f32x4 a = *(const f32x4*)(F.inp(31) + k * NUP + cg), b = *(const f32x4*)(F.inp(31) + k * NUP + cg + 4), d = *(const f32x4*)(F.inp(31) + k * NUP + cv), e = *(const f32x4*)(F.inp(31) + k * NUP + cv + 4);
        wg[k][0] = a.x; wg[k][1] = a.y; wg[k][2] = a.z; wg[k][3] = a.w; wg[k][4] = b.x; wg[k][5] = b.y; wg[k][6] = b.z; wg[k][7] = b.w;
        wv[k][0] = d.x; wv[k][1] = d.y; wv[k][2] = d.z; wv[k][3] = d.w; wv[k][4] = e.x; wv[k][5] = e.y; wv[k][6] = e.z; wv[k][7] = e.w; }
    { const f32x4 a = *(const f32x4*)(F.inp(32) + cg), b = *(const f32x4*)(F.inp(32) + cg + 4), d = *(const f32x4*)(F.inp(32) + cv), e = *(const f32x4*)(F.inp(32) + cv + 4);
      bg[0] = a.x; bg[1] = a.y; bg[2] = a.z; bg[3] = a.w; bg[4] = b.x; bg[5] = b.y; bg[6] = b.z; bg[7] = b.w;
      bv[0] = d.x; bv[1] = d.y; bv[2] = d.z; bv[3] = d.w; bv[4] = e.x; bv[5] = e.y; bv[6] = e.z; bv[7] = e.w; }
    if (!act) return;
    for (int tile = F.vcu; tile < MA / 16; tile += F.G) {
        const int m0 = tile * 16; const bool samp = (m0 >= MP);
        const bf16* upg = ((bf16*)(F.ws + WS_UP)) + (size_t)m0 * NUP + cg; const bf16* upv = ((bf16*)(F.ws + WS_UP)) + (size_t)m0 * NUP + cv;
        v4u rg[2][4], rv[2][4];
#pragma unroll
        for (int i = 0; i < 4; ++i) { rg[0][i] = *(const v4u*)(upg + (size_t)i * NUP); rv[0][i] = *(const v4u*)(upv + (size_t)i * NUP); }
        float g2[8], v2[8], g1[8], v1[8];
        if (!samp) {
            if ((m0 & (SEQ - 1)) == 0) {
#pragma unroll
                for (int j = 0; j < 8; ++j) { g2[j] = 0.f; v2[j] = 0.f; g1[j] = 0.f; v1[j] = 0.f; } }
            else { unpack8(*(const v4u*)(upg - 2 * (size_t)NUP), g2); unpack8(*(const v4u*)(upv - 2 * (size_t)NUP), v2);
                   unpack8(*(const v4u*)(upg - (size_t)NUP), g1); unpack8(*(const v4u*)(upv - (size_t)NUP), v1); }
        }
#pragma unroll
        for (int bt = 0; bt < 4; ++bt) {
            const int cb = bt & 1, nb = cb ^ 1;
            if (bt < 3) {
#pragma unroll
                for (int i = 0; i < 4; ++i) { rg[nb][i] = *(const v4u*)(upg + (size_t)(4 * bt + 4 + i) * NUP); rv[nb][i] = *(const v4u*)(upv + (size_t)(4 * bt + 4 + i) * NUP); } }
            if (samp) {
                const float* sp = F.inp(7) + (size_t)((m0 + 4 * bt - MP) >> 2) * 2 * NUP;
                const f32x4 a = *(const f32x4*)(sp + cg), b = *(const f32x4*)(sp + cg + 4), d = *(const f32x4*)(sp + cv), e = *(const f32x4*)(sp + cv + 4);
                const f32x4 a1 = *(const f32x4*)(sp + NUP + cg), b1 = *(const f32x4*)(sp + NUP + cg + 4), d1 = *(const f32x4*)(sp + NUP + cv), e1 = *(const f32x4*)(sp + NUP + cv + 4);
                g2[0] = a.x; g2[1] = a.y; g2[2] = a.z; g2[3] = a.w; g2[4] = b.x; g2[5] = b.y; g2[6] = b.z; g2[7] = b.w;
                v2[0] = d.x; v2[1] = d.y; v2[2] = d.z; v2[3] = d.w; v2[4] = e.x; v2[5] = e.y; v2[6] = e.z; v2[7] = e.w;
                g1[0] = a1.x; g1[1] = a1.y; g1[2] = a1.z; g1[3] = a1.w; g1[4] = b1.x; g1[5] = b1.y; g1[6] = b1.z; g1[7] = b1.w;
                v1[0] = d1.x; v1[1] = d1.y; v1[2] = d1.z; v1[3] = d1.w; v1[4] = e1.x; v1[5] = e1.y; v1[6] = e1.z; v1[7] = e1.w; }
#pragma unroll
            for (int i = 0; i < 4; ++i) {
                const int m = m0 + 4 * bt + i;
                float g0[8], v0[8]; unpack8(rg[cb][i], g0); unpack8(rv[cb][i], v0);
                float o[8];
#pragma unroll
                for (int j = 0; j < 8; ++j) { const float hg = bg[j] + wg[0][j] * g2[j] + wg[1][j] * g1[j] + wg[2][j] * g0[j], hv = bv[j] + wv[0][j] * v2[j] + wv[1][j] * v1[j] + wv[2][j] * v0[j];
                    o[j] = hg / (1.0f + __expf(-hg)) * hv; }
                *(v4u*)(((bf16*)(F.ws + WS_ACT)) + (size_t)m * DFF + cg) = pack8(o);
                const int tt = samp ? ((m - MP) & 3) : (m & (SEQ - 1)); const int kk = samp ? tt - 2 : tt - (SEQ - 2);
                if (kk >= 0) { float* fo = samp ? F.out + O_FCS + ((size_t)((m - MP) >> 2) * 2 + kk) * NUP : F.out + O_FCP + ((size_t)(m >> 12) * 2 + kk) * NUP;
                    *(f32x4*)(fo + cg) = (f32x4){g0[0], g0[1], g0[2], g0[3]}; *(f32x4*)(fo + cg + 4) = (f32x4){g0[4], g0[5], g0[6], g0[7]};
                    *(f32x4*)(fo + cv) = (f32x4){v0[0], v0[1], v0[2], v0[3]}; *(f32x4*)(fo + cv + 4) = (f32x4){v0[4], v0[5], v0[6], v0[7]}; }
#pragma unroll
                for (int j = 0; j < 8; ++j) { g2[j] = g1[j]; v2[j] = v1[j]; g1[j] = g0[j]; v1[j] = v0[j]; }
            }
        }
    }
}

struct Args { const void* in[34]; float* out; unsigned char* ws; int ph_lo, ph_hi; };
constexpr int N_PHASES = 12;
__global__ void __launch_bounds__(NWAVES * 64, 2) mk_fwd(Args args) {
    extern __shared__ __attribute__((aligned(16))) unsigned char lds[];
    Frame F;
    F.lds = (LAS unsigned char*)lds;
    F.MISC = (volatile LAS unsigned*)(F.lds + MISC_OFF);
    F.tid = threadIdx.x; F.lane = F.tid & 63; F.wave = __builtin_amdgcn_readfirstlane(F.tid >> 6);
    F.G = gridDim.x; { const int bx = blockIdx.x; F.vcu = (F.G % 8 == 0) ? (bx % 8) * (F.G / 8) + bx / 8 : bx; }
    unsigned char* ws = (unsigned char*)(GAS unsigned char*)args.ws;
    F.ctl = (gu32*)(ws + WS_CTL);
    F.kin = (KIN)__builtin_amdgcn_kernarg_segment_ptr(); F.ws = ws; F.out = (float*)(GAS float*)args.out;
    for (int u = F.tid; u < (LDS_BYTES - LDSCTL_OFF) / 4; u += NWAVES * 64) ((LAS unsigned*)(F.lds + LDSCTL_OFF))[u] = 0u;
    __syncthreads();
    const int lo = args.ph_lo, hi = args.ph_hi;
    const bool one_launch = (hi - lo) > 1;
    XcdBarrier bar; bar.bar = (unsigned*)(F.ctl + CW_BAR); bar.x = 0; bar.st = nullptr;
    if (one_launch) bar = xcd_barrier_post((unsigned*)(F.ctl + CW_BAR), F.MISC + 8);
#define IN(k) (lo <= (k) && (k) < hi)
#define PHASE_IDS() do { int t_ = threadIdx.x; asm volatile("" : "+v"(t_)); F.tid = t_; F.lane = t_ & 63; } while (0)
#ifndef MK_REPEAT
#define MK_REPEAT 0
#endif
#define REP(k) for (int rep_ = 0; rep_ < (((MK_REPEAT >> (k)) & 1) + 1); ++rep_)
#define REPBAR() do { if (rep_ > 0) xcd_barrier(bar); } while (0)
#define SEAM(k) do { if (IN(k) && IN((k) + 1)) xcd_barrier(bar); } while (0)

    if (IN(0)) REP(0) { REPBAR(); PHASE_IDS(); p0_prologue(F); } SEAM(0);
    if (IN(1)) REP(1) { REPBAR(); PHASE_IDS(); pg8::Gemm g{((bf16*)(F.ws + WS_SC)), ((bf16*)(F.ws + WS_WADA)), 256, NADA, DM}; pg8::StaticOrder S; S.init(256, NADA, F.G, (int)blockIdx.x);
        pg8::EpiF32Bias E{((float*)(F.ws + WS_MOD)), NADA, F.inp(13)};
        pg8::gemm_phase<pg8::EpiF32Bias, pg8::StaticOrder, PG8_ALIGN, PG8_SP2>(F.lds + RING_OFF, g, S, E); } SEAM(1);
    if (IN(2)) REP(2) { REPBAR(); PHASE_IDS(); norm_mod_rows(F, F.inp(0), F.inp(1), F.inp(10), 1024, 0); } SEAM(2);
    if (IN(3)) REP(3) { REPBAR(); PHASE_IDS(); pg8::Gemm g{((bf16*)(F.ws + WS_XN)), ((bf16*)(F.ws + WS_WIN)), MA, NIN, DM}; pg8::StaticOrder S; S.init(MA, NIN, F.G, (int)blockIdx.x);
        pg8::EpiBf16<0> E{((bf16*)(F.ws + WS_PROJ)), NIN, nullptr, 0, 0, 1.f};
        pg8::gemm_phase<pg8::EpiBf16<0>, pg8::StaticOrder, PG8_ALIGN, PG8_SP2>(F.lds + RING_OFF, g, S, E); } SEAM(3);
    if (IN(4)) REP(4) { REPBAR(); PHASE_IDS(); p4_phase(F); } SEAM(4);
    if (IN(5)) REP(5) { REPBAR(); PHASE_IDS();
        const int home = (int)(xb_xcc_id() & 7u);
        const bool sfirst = ((blockIdx.x >> 3) & 3) == 3;
        const float lam = diff_lambda(F);
        for (int pass = 0; pass < 2; ++pass) {
            const int kind = ((pass == 0) == sfirst) ? 1 : 0;
#if defined(MK_P5_REP_ONLY)
            if (rep_ > 0 && kind != MK_P5_REP_ONLY) continue;
#if defined(MK_P5_REP_SFIRST)
            if (rep_ > 0 && !sfirst) continue;
#endif
#endif
            for (int dq = 0; dq < 8; ++dq) { const int q = (home + dq) & 7;
                for (;;) { const int idx = q_pop(F, kind, q, rep_); if (idx >= (kind ? 32 : 128)) break;
                    if (kind == 0) {
                        const int qb = 15 - (idx >> 3), bvh = 8 * q + (idx & 7), b = bvh >> 4, vh = bvh & 15, h = vh >> 2, c = (vh >> 1) & 1, half = vh & 1;
                        attn_body::attn_unit<8>(b, qb, (const attn_body::bf16*)((bf16*)(F.ws + WS_QB)) + h * 128 + c * 64, (const attn_body::bf16*)((bf16*)(F.ws + WS_KB)) + h * 128 + c * 64,
                                                (const attn_body::bf16*)((bf16*)(F.ws + WS_PROJ)) + 1024 + h * 128 + half * 64, (attn_body::bf16*)((bf16*)(F.ws + WS_OB)) + vh * 64, (char*)lds + RING_OFF);
                    } else { PHASE_IDS(); const int u = 32 * q + idx; sattn_unit(F, u >> 1, u & 1, lam); }
                } }
        }
    } SEAM(5);
    if (IN(6)) REP(6) { REPBAR(); PHASE_IDS(); const float lam = diff_lambda(F); int tp = F.vcu, tq = F.G - 1 - F.vcu;
        for (;;) { int m0, nrows; if (tp < 256) { m0 = 64 * tp; nrows = 64; tp += F.G; } else if (tq < 32) { m0 = MP + 16 * tq; nrows = 16; tq += F.G; } else break; p6_tile(F, m0, nrows, lam); } } SEAM(6);
    if (IN(7)) REP(7) { REPBAR(); PHASE_IDS(); sample_gemm<DM>(F, ((bf16*)(F.ws + WS_MIX)), ((bf16*)(F.ws + WS_WOUT)), F.inp(1), ((float*)(F.ws + WS_MOD)) + 2048, ((float*)(F.ws + WS_X1)));
        pg8::Gemm g{((bf16*)(F.ws + WS_MIX)), ((bf16*)(F.ws + WS_WOUT)), MP, DM, DM}; pg8::StaticOrder S; S.init(MP, DM, F.G, (int)blockIdx.x);
        pg8::EpiResGate E{F.inp(0), F.inp(1), ((float*)(F.ws + WS_MOD)) + 2048, ((float*)(F.ws + WS_X1))};
        pg8::gemm_phase<pg8::EpiResGate, pg8::StaticOrder, PG8_ALIGN, PG8_SP2>(F.lds + RING_OFF, g, S, E); } SEAM(7);
    if (IN(8)) REP(8) { REPBAR(); PHASE_IDS(); norm_mod_rows(F, ((float*)(F.ws + WS_X1)), ((float*)(F.ws + WS_X1)) + (size_t)MP * DM, F.inp(11), 4096, 3072); } SEAM(8);
    if (IN(9)) REP(9) { REPBAR(); PHASE_IDS(); pg8::Gemm g{((bf16*)(F.ws + WS_XN)), ((bf16*)(F.ws + WS_WUP)), MA, NUP, DM}; pg8::StaticOrder S; S.init(MA, NUP, F.G, (int)blockIdx.x);
        pg8::EpiBf16<0> E{((bf16*)(F.ws + WS_UP)), NUP, nullptr, 0, 0, 1.f};
        pg8::gemm_phase<pg8::EpiBf16<0>, pg8::StaticOrder, PG8_ALIGN, PG8_SP2>(F.lds + RING_OFF, g, S, E); } SEAM(9);
    if (IN(10)) REP(10) { REPBAR(); PHASE_IDS(); p10_phase(F); } SEAM(10);
    if (IN(11)) REP(11) { REPBAR(); PHASE_IDS(); sample_gemm<DFF>(F, ((bf16*)(F.ws + WS_ACT)), ((bf16*)(F.ws + WS_WDN)), ((float*)(F.ws + WS_X1)) + (size_t)MP * DM, ((float*)(F.ws + WS_MOD)) + 5120, F.out);
        pg8::Gemm g{((bf16*)(F.ws + WS_ACT)), ((bf16*)(F.ws + WS_WDN)), MP, DM, DFF}; pg8::StaticOrder S; S.init(MP, DM, F.G, (int)blockIdx.x);
        pg8::EpiResGate E{((float*)(F.ws + WS_X1)), ((float*)(F.ws + WS_X1)) + (size_t)MP * DM, ((float*)(F.ws + WS_MOD)) + 5120, F.out};
        pg8::gemm_phase<pg8::EpiResGate, pg8::StaticOrder, PG8_ALIGN, PG8_SP2>(F.lds + RING_OFF, g, S, E); }
#undef IN
#undef SEAM
}

#ifndef MK_N_LAUNCHES
#define MK_N_LAUNCHES 1
#endif
extern "C" void kernel_launch(void* const* d_in, const int* in_sizes, int n_in, void* d_out, int out_size, void* d_ws, size_t ws_size, hipStream_t stream) {
    static int grid = 0;
    if (grid == 0) {
        if (n_in != 34 || out_size != (int)O_END || ws_size < WS_END) { fprintf(stderr, "kernel_launch: unexpected shapes: n_in %d out %d ws %zu\n", n_in, out_size, ws_size); grid = -1; return; }
        int dev = 0, cus = 0, per_cu = 0;
        if (hipGetDevice(&dev) != hipSuccess || hipDeviceGetAttribute(&cus, hipDeviceAttributeMultiprocessorCount, dev) != hipSuccess) { grid = -1; return; }
        if (hipFuncSetAttribute((const void*)mk_fwd, hipFuncAttributeMaxDynamicSharedMemorySize, LDS_BYTES) != hipSuccess) { fprintf(stderr, "kernel_launch: hipFuncSetAttribute failed\n"); grid = -1; return; }
        if (hipOccupancyMaxActiveBlocksPerMultiprocessor(&per_cu, (const void*)mk_fwd, NWAVES * 64, LDS_BYTES) != hipSuccess || per_cu < 1) { fprintf(stderr, "kernel_launch: occupancy query says %d\n", per_cu); }
        (void)hipGetLastError();
        grid = cus;
    }
    if (grid < 0) return;
    if (hipMemsetAsync((char*)d_ws + WS_CTL, 0, CTL_ZERO_BYTES, stream) != hipSuccess) return;
    Args a{};
    for (int i = 0; i < 34; ++i) a.in[i] = d_in[i];
    a.out = (float*)d_out; a.ws = (unsigned char*)d_ws;
    if (MK_N_LAUNCHES == 1) { a.ph_lo = 0; a.ph_hi = N_PHASES; hipLaunchKernelGGL(mk_fwd, dim3(grid), dim3(NWAVES * 64), LDS_BYTES, stream, a); }
    else { for (int p = 0; p < N_PHASES; ++p) { a.ph_lo = p; a.ph_hi = p + 1; hipLaunchKernelGGL(mk_fwd, dim3(grid), dim3(NWAVES * 64), LDS_BYTES, stream, a); } }
}
```

```cpp
#include <hip/hip_runtime.h>
#include <cstdio>
#include <cstdint>
namespace pg8 {
#define PG8_LAS __attribute__((address_space(3)))
typedef unsigned short bf16_t;
typedef short bf16x8 __attribute__((ext_vector_type(8)));
typedef float f32x4 __attribute__((ext_vector_type(4)));
typedef unsigned u32x4 __attribute__((ext_vector_type(4)));
constexpr int BM = 256, BK = 64, HALF = 128, HTB = HALF * BK * 2  , STAGE_BYTES = 8 * HTB, NXCD = 8, WGM = 8;

__host__ __device__ __forceinline__ int lds_byte(int r, int c) { const int st = (r >> 4) * 2 + (c >> 5), rr = r & 15, cc = c & 31, ob = rr * 64 + cc * 2; return st * 1024 + (ob ^ (((ob >> 9) & 1) << 5)); }
__host__ __device__ __forceinline__ void stage_rc(int b, int& R, int& C) { const int st = b / 1024, sb = b % 1024, swz = sb ^ (((sb >> 9) & 1) << 5); R = (st >> 1) * 16 + swz / 64; C = (st & 1) * 32 + (swz % 64) / 2; }
__host__ __device__ __forceinline__ int perm32(int rho) { const int n = rho >> 4, i = rho & 15; return 8 * (i >> 2) + 4 * n + (i & 3); }

struct Unit { int pm, pn; };
struct Gemm { const bf16_t* A; const bf16_t* Bt; int M, N, K; };

struct StaticOrder {
    int nM, nN, nwg, G, c;
    __host__ __device__ void init(int M, int N, int G_, int c_) { nM = M / BM; nN = N / BM; nwg = nM * nN; G = G_; c = c_; }
    __host__ __device__ bool next(int i, Unit& u) const {
        const long L = (long)i * G + c; if (L >= nwg) return false;
        int wgid = (int)L; { const int q = nwg / NXCD, r = nwg % NXCD, xcd = wgid % NXCD, off = wgid / NXCD; wgid = (xcd < r ? xcd * (q + 1) : r * (q + 1) + (xcd - r) * q) + off; }
        const int nig = WGM * nN, gid = wgid / nig, fm = gid * WGM, gsz = (nM - fm) < WGM ? (nM - fm) : WGM;
        u.pm = fm + ((wgid % nig) % gsz); u.pn = (wgid % nig) / gsz; return true;
    }
    __device__ __forceinline__ void a_ready(const Unit&) const {}
    __device__ __forceinline__ void done(const Unit&) const {}
};

__device__ __forceinline__ unsigned cvt_pk_bf16(float lo, float hi) { unsigned r; asm volatile("v_cvt_pk_bf16_f32 %0, %1, %2" : "=v"(r) : "v"(lo), "v"(hi)); return r; }
typedef float f32x2 __attribute__((ext_vector_type(2)));
__device__ __forceinline__ f32x2 gelu_pk(f32x2 v) {
    const f32x2 av = __builtin_elementwise_abs(v), d = av * 0.2316418882f + 1.0f;
    f32x2 t; t.x = __builtin_amdgcn_rcpf(d.x); t.y = __builtin_amdgcn_rcpf(d.y);
    f32x2 q = t * 0.5307027145f + (-0.7265760135f); q = q * t + 0.7107068705f; q = q * t + (-0.142248368f); q = q * t + 0.127414796f; q = q * t;
    const f32x2 s = (v * v) * (-0.72134752044f);
    f32x2 e; e.x = __builtin_amdgcn_exp2f(s.x); e.y = __builtin_amdgcn_exp2f(s.y);
    const f32x2 m = v * (q * e), r = v - m;
    f32x2 o; o.x = v.x < 0.f ? m.x : r.x; o.y = v.y < 0.f ? m.y : r.y; return o;
}

template <int ACT  > struct EpiBf16 {
    static constexpr bool PERM = true, AFTER_DRAIN = false; static_assert(ACT == 0 || ACT == 1, "EpiBf16: ACT is 0 (none) or 1 (gelu_pk)");
    bf16_t* O; int ldc; const float* bias; int split_cols; size_t split_stride; float scale0;
    __device__ __forceinline__ void operator()(const f32x4 (&acc)[2][2][4][2], const Unit& u, int wr, int wc, int fr, int fq) const {
        const int row0 = u.pm * BM + wr * 64 + fr; int colt = u.pn * BM; bf16_t* base = O;
        float sc = 1.f; if (split_cols) { const int t = colt / split_cols; base += (size_t)t * split_stride; colt -= t * split_cols; if (t == 0) sc = scale0; }
        const int col0 = colt + wc * 32 + 8 * fq, bcol0 = u.pn * BM + wc * 32 + 8 * fq;
        f32x4 bv[2][2];
#pragma unroll
        for (int bj = 0; bj < 2; ++bj)
#pragma unroll
            for (int n = 0; n < 2; ++n) bv[bj][n] = bias ? *(const f32x4*)(bias + bcol0 + bj * HALF + 4 * n) : (f32x4){0.f, 0.f, 0.f, 0.f};
#pragma unroll
        for (int ai = 0; ai < 2; ++ai)
#pragma unroll
            for (int m = 0; m < 4; ++m) { bf16_t* rowp = base + (size_t)(row0 + ai * HALF + m * 16) * ldc + col0;
#pragma unroll
                for (int bj = 0; bj < 2; ++bj) { f32x4 v0 = acc[ai][bj][m][0] + bv[bj][0], v1 = acc[ai][bj][m][1] + bv[bj][1];
                    if (ACT == 1) { f32x2 a = gelu_pk((f32x2){v0[0], v0[1]}), b = gelu_pk((f32x2){v0[2], v0[3]}), c = gelu_pk((f32x2){v1[0], v1[1]}), d = gelu_pk((f32x2){v1[2], v1[3]});
                        v0 = (f32x4){a.x, a.y, b.x, b.y}; v1 = (f32x4){c.x, c.y, d.x, d.y}; }
                    v0 = v0 * sc; v1 = v1 * sc; u32x4 w; w.x = cvt_pk_bf16(v0[0], v0[1]); w.y = cvt_pk_bf16(v0[2], v0[3]); w.z = cvt_pk_bf16(v1[0], v1[1]); w.w = cvt_pk_bf16(v1[2], v1[3]);
                    *(u32x4*)(rowp + bj * HALF) = w; } }
    }
};

constexpr int MPROMPT = 16384;
struct EpiF32Bias {
    static constexpr bool PERM = false, AFTER_DRAIN = false;
    float* out; int ldc; const float* bias;
    __device__ __forceinline__ void operator()(const f32x4 (&acc)[2][2][4][2], const Unit& u, int wr, int wc, int fr, int fq) const {
        const int col0 = u.pn * BM + wc * 32 + 4 * fq;
        f32x4 bv[2][2];
#pragma unroll
        for (int bj = 0; bj < 2; ++bj)
#pragma unroll
            for (int n = 0; n < 2; ++n) bv[bj][n] = *(const f32x4*)(bias + col0 + bj * HALF + n * 16);
#pragma unroll
        for (int ai = 0; ai < 2; ++ai)
#pragma unroll
            for (int m = 0; m < 4; ++m) { float* rp = out + (size_t)(u.pm * BM + ai * HALF + wr * 64 + m * 16 + fr) * ldc + col0;
#pragma unroll
                for (int bj = 0; bj < 2; ++bj)
#pragma unroll
                    for (int n = 0; n < 2; ++n) *(f32x4*)(rp + bj * HALF + n * 16) = acc[ai][bj][m][n] + bv[bj][n]; }
    }
};
struct EpiResGate {
    static constexpr bool PERM = false, AFTER_DRAIN = false;
    const float* bp; const float* bs;
    const float* gate;
    float* out;
    __device__ __forceinline__ void operator()(const f32x4 (&acc)[2][2][4][2], const Unit& u, int wr, int wc, int fr, int fq) const {
        const int col0 = u.pn * BM + wc * 32 + 4 * fq;
#pragma unroll
        for (int ai = 0; ai < 2; ++ai)
#pragma unroll
            for (int m = 0; m < 4; ++m) { const int row = u.pm * BM + ai * HALF + wr * 64 + m * 16 + fr;
                const float* b = (row < MPROMPT) ? bp + (size_t)row * 1024 : bs + (size_t)(row - MPROMPT) * 1024;
                const int mr = (row < MPROMPT) ? (row >> 12) : 4 + ((row - MPROMPT) >> 2);
                const float* g = gate + (size_t)mr * 6144; float* o = out + (size_t)row * 1024;
#pragma unroll
                for (int bj = 0; bj < 2; ++bj)
#pragma unroll
                    for (int n = 0; n < 2; ++n) { const int c = col0 + bj * HALF + n * 16; const f32x4 bb = *(const f32x4*)(b + c), gg = *(const f32x4*)(g + c);
                        *(f32x4*)(o + c) = bb + gg * acc[ai][bj][m][n]; }
                if (m & 1) asm volatile("" ::: "memory"); }
    }
};
template <int CTRL> __device__ __forceinline__ float dpp_mov_f(float x) { return __builtin_bit_cast(float, __builtin_amdgcn_mov_dpp(__builtin_bit_cast(int, x), CTRL, 0xf, 0xf, true)); }
template <int CTRL> __device__ __forceinline__ float dpp_upd_f(float old, float x) { return __builtin_bit_cast(float, __builtin_amdgcn_update_dpp(__builtin_bit_cast(int, old), __builtin_bit_cast(int, x), CTRL, 0xf, 0xf, false)); }
struct EpiConvGate {
    static constexpr bool PERM = true, AFTER_DRAIN = false;
    bf16_t* ACT; bf16_t* UP; bf16_t* EDGE; const float* cw; const float* cb; float* fcp; PG8_LAS float* H;
    __device__ __forceinline__ void operator()(const f32x4 (&acc)[2][2][4][2], const Unit& u, int wr, int wc, int fr, int fq) const {
        const int c0 = 128 * u.pn + 32 * wc + 8 * fq;
        if (u.pm >= 64) {
#pragma unroll
            for (int ai = 0; ai < 2; ++ai)
#pragma unroll
                for (int m = 0; m < 4; ++m) { bf16_t* rp = UP + (size_t)(u.pm * BM + ai * HALF + wr * 64 + m * 16 + fr) * 5632 + c0;
#pragma unroll
                    for (int bj = 0; bj < 2; ++bj) { const f32x4 v0 = acc[ai][bj][m][0], v1 = acc[ai][bj][m][1]; u32x4 w; w.x = cvt_pk_bf16(v0[0], v0[1]); w.y = cvt_pk_bf16(v0[2], v0[3]); w.z = cvt_pk_bf16(v1[0], v1[1]); w.w = cvt_pk_bf16(v1[2], v1[3]);
                        *(u32x4*)(rp + bj * 2816) = w; } }
            __builtin_amdgcn_s_barrier();
            return;
        }
#pragma unroll
        for (int ai = 0; ai < 2; ++ai)
            if (fr >= 14) {
#pragma unroll
                for (int bj = 0; bj < 2; ++bj)
#pragma unroll
                    for (int n = 0; n < 2; ++n) *(PG8_LAS f32x4*)(H + (((ai * 2 + wr) * 2 + (fr - 14)) * 256 + 128 * bj + 32 * wc + 8 * fq + 4 * n)) = acc[ai][bj][3][n];
            }
        asm volatile("s_waitcnt lgkmcnt(0)" ::: "memory"); __builtin_amdgcn_s_barrier(); asm volatile("" ::: "memory");
        typedef unsigned u32x2e __attribute__((ext_vector_type(2)));
#pragma unroll
        for (int n = 0; n < 2; ++n) {
            float wg[3][4], wv[3][4], bg[4], bv[4];
#pragma unroll
            for (int k = 0; k < 3; ++k) { const f32x4 a = *(const f32x4*)(cw + k * 5632 + c0 + 4 * n), d = *(const f32x4*)(cw + k * 5632 + 2816 + c0 + 4 * n);
                wg[k][0] = a[0]; wg[k][1] = a[1]; wg[k][2] = a[2]; wg[k][3] = a[3]; wv[k][0] = d[0]; wv[k][1] = d[1]; wv[k][2] = d[2]; wv[k][3] = d[3]; }
            { const f32x4 a = *(const f32x4*)(cb + c0 + 4 * n), d = *(const f32x4*)(cb + 2816 + c0 + 4 * n);
              bg[0] = a[0]; bg[1] = a[1]; bg[2] = a[2]; bg[3] = a[3]; bv[0] = d[0]; bv[1] = d[1]; bv[2] = d[2]; bv[3] = d[3]; }
#pragma unroll
            for (int ai = 0; ai < 2; ++ai)
#pragma unroll
                for (int m = 0; m < 4; ++m) {
                    const int blk = ai * 2 + wr;
                    f32x4 pg, pvv;
                    if (m > 0) { pg = acc[ai][0][m - 1][n]; pvv = acc[ai][1][m - 1][n]; }
                    else { const PG8_LAS float* hp = H + ((((blk > 0 ? blk - 1 : 0) * 2 + (fr >= 14 ? fr - 14 : 0)) * 256) + 32 * wc + 8 * fq + 4 * n);
                           pg = *(const PG8_LAS f32x4*)hp; pvv = *(const PG8_LAS f32x4*)(hp + 128); }
                    float o[4];
#pragma unroll
                    for (int i = 0; i < 4; ++i) {
                        const float cg_ = acc[ai][0][m][n][i], cv_ = acc[ai][1][m][n][i];
                        const float mg = dpp_mov_f<0x140>(pg[i]), mv = dpp_mov_f<0x140>(pvv[i]);
                        const float g1 = dpp_upd_f<0x111>(mg, cg_), v1 = dpp_upd_f<0x111>(mv, cv_);
                        const float g2 = dpp_upd_f<0x112>(dpp_mov_f<0xB1>(mg), cg_), v2 = dpp_upd_f<0x112>(dpp_mov_f<0xB1>(mv), cv_);
                        const float hg = bg[i] + wg[0][i] * g2 + wg[1][i] * g1 + wg[2][i] * cg_, hv = bv[i] + wv[0][i] * v2 + wv[1][i] * v1 + wv[2][i] * cv_;
                        o[i] = hg * __builtin_amdgcn_rcpf(1.0f + __expf(-hg)) * hv; }
                    u32x2e w; w.x = cvt_pk_bf16(o[0], o[1]); w.y = cvt_pk_bf16(o[2], o[3]);
                    if (!(blk == 0 && m == 0 && fr < 2)) *(u32x2e*)(ACT + (size_t)(u.pm * BM + ai * HALF + wr * 64 + m * 16 + fr) * 2816 + c0 + 4 * n) = w;
                }
        }
        if (wr == 0 && fr < 2) {
#pragma unroll
            for (int bj = 0; bj < 2; ++bj) { const f32x4 v0 = acc[0][bj][0][0], v1 = acc[0][bj][0][1]; u32x4 w; w.x = cvt_pk_bf16(v0[0], v0[1]); w.y = cvt_pk_bf16(v0[2], v0[3]); w.z = cvt_pk_bf16(v1[0], v1[1]); w.w = cvt_pk_bf16(v1[2], v1[3]);
                *(u32x4*)(EDGE + (size_t)(u.pm * 4 + fr) * 5632 + bj * 2816 + c0) = w; }
        }
        if (wr == 1 && fr >= 14) {
#pragma unroll
            for (int bj = 0; bj < 2; ++bj) { const f32x4 v0 = acc[1][bj][3][0], v1 = acc[1][bj][3][1]; u32x4 w; w.x = cvt_pk_bf16(v0[0], v0[1]); w.y = cvt_pk_bf16(v0[2], v0[3]); w.z = cvt_pk_bf16(v1[0], v1[1]); w.w = cvt_pk_bf16(v1[2], v1[3]);
                *(u32x4*)(EDGE + (size_t)(u.pm * 4 + 2 + (fr - 14)) * 5632 + bj * 2816 + c0) = w;
                if ((u.pm & 15) == 15) { float* fo = fcp + (size_t)((u.pm >> 4) * 2 + (fr - 14)) * 5632 + bj * 2816 + c0; *(f32x4*)fo = v0; *(f32x4*)(fo + 4) = v1; } }
        }
    }
};
template <class Epi, class Sched, bool ALIGN_EPI = false, bool SP2 = false>
__device__ __forceinline__ void gemm_phase(PG8_LAS unsigned char* lds, const Gemm g, const Sched& S, const Epi& E) {
    const int tid = threadIdx.x, wid = __builtin_amdgcn_readfirstlane(tid >> 6), lane = tid & 63, wr = wid >> 2, wc = wid & 3, fr = lane & 15, fq = lane >> 4;
    const int K = g.K, nt = K / BK;
    unsigned voffA[2], voffB[2];
#pragma unroll
    for (int i = 0; i < 2; ++i) { int R, C; stage_rc(tid * 16 + i * 8192, R, C); const int Rb = Epi::PERM ? ((R & ~31) + perm32(R & 31)) : R;
        voffA[i] = (unsigned)(R * K + C) * 2u; voffB[i] = (unsigned)(Rb * K + C) * 2u; }
    const size_t kstep = (size_t)(BK * 2);
    const size_t hstep = (size_t)HALF * K * 2;
    const size_t tstep = 2 * hstep;
    const unsigned ldsw = (unsigned)wid * 1024u;
    const int aoff = lds_byte(wr * 64 + fr, fq * 8), boff = lds_byte(wc * 32 + fr, fq * 8);
#define PG8_SA(b, h) (((b) * 2 + (h)) * HTB)
#define PG8_SB(b, h) ((4 + (b) * 2 + (h)) * HTB)
#define PG8_STAGE(bufoff, gbase, voff) do { _Pragma("unroll") for (int _i = 0; _i < 2; ++_i) \
        __builtin_amdgcn_global_load_lds((const unsigned*)((const char*)(gbase) + (voff)[_i]), (PG8_LAS unsigned*)(lds + (bufoff) + ldsw + _i * 8192), 16, 0, 0); } while (0)
#define PG8_LDA(dst, b, h) do { _Pragma("unroll") for (int m = 0; m < 4; ++m) _Pragma("unroll") for (int k = 0; k < 2; ++k) dst[m][k] = *(const PG8_LAS bf16x8*)(lds + PG8_SA(b, h) + aoff + m * 2048 + k * 1024); } while (0)
#define PG8_LDB(dst, b, h) do { _Pragma("unroll") for (int n = 0; n < 2; ++n) _Pragma("unroll") for (int k = 0; k < 2; ++k) dst[n][k] = *(const PG8_LAS bf16x8*)(lds + PG8_SB(b, h) + boff + n * 2048 + k * 1024); } while (0)
#define PG8_MMA(ai, bj, At, Bt) do { __builtin_amdgcn_s_setprio(1); _Pragma("unroll") for (int m = 0; m < 4; ++m) _Pragma("unroll") for (int n = 0; n < 2; ++n) _Pragma("unroll") for (int k = 0; k < 2; ++k) \
        acc[ai][bj][m][n] = __builtin_amdgcn_mfma_f32_16x16x32_bf16(Bt[n][k], At[m][k], acc[ai][bj][m][n], 0, 0, 0); __builtin_amdgcn_s_setprio(0); } while (0)
#define PG8_WAIT_V(n) asm volatile("s_waitcnt vmcnt(" #n ")" ::: "memory")
#define PG8_WAIT_L(n) asm volatile("s_waitcnt lgkmcnt(" #n ")" ::: "memory")
#define PG8_BAR __builtin_amdgcn_s_barrier()
#define PG8_SCHED __builtin_amdgcn_sched_barrier(0)
    Unit cur, nxt; int ui = 0;
    if (!S.next(0, cur)) return;
    f32x4 acc[2][2][4][2];
#pragma unroll
    for (int a = 0; a < 2; ++a)
#pragma unroll
        for (int b = 0; b < 2; ++b)
#pragma unroll
            for (int m = 0; m < 4; ++m)
#pragma unroll
                for (int n = 0; n < 2; ++n) acc[a][b][m][n] = (f32x4){0.f, 0.f, 0.f, 0.f};
    bf16x8 At[4][2], B0[2][2], B1[2][2];
    const char* cA = (const char*)g.A + (size_t)cur.pm * tstep; const char* cB = (const char*)g.Bt + (size_t)cur.pn * tstep;
    S.a_ready(cur);
    if constexpr (SP2) {
        PG8_STAGE(PG8_SB(0, 0), cB, voffB); PG8_STAGE(PG8_SB(0, 1), cB + hstep, voffB); PG8_STAGE(PG8_SA(0, 0), cA, voffA); PG8_STAGE(PG8_SA(0, 1), cA + hstep, voffA);
        if (wr == 1) PG8_BAR;
        PG8_WAIT_V(2); PG8_BAR;
        PG8_STAGE(PG8_SB(1, 0), cB + kstep, voffB); PG8_STAGE(PG8_SA(1, 0), cA + kstep, voffA); PG8_STAGE(PG8_SB(1, 1), cB + hstep + kstep, voffB);
        PG8_WAIT_V(6); PG8_BAR;
    } else {
        PG8_STAGE(PG8_SB(0, 0), cB, voffB); PG8_STAGE(PG8_SA(0, 0), cA, voffA); PG8_STAGE(PG8_SB(0, 1), cB + hstep, voffB); PG8_STAGE(PG8_SA(0, 1), cA + hstep, voffA);
        if (wr == 1) PG8_BAR;
        PG8_WAIT_V(4); PG8_BAR;
        PG8_STAGE(PG8_SB(1, 0), cB + kstep, voffB); PG8_STAGE(PG8_SA(1, 0), cA + kstep, voffA); PG8_STAGE(PG8_SB(1, 1), cB + hstep + kstep, voffB);
        PG8_WAIT_V(6); PG8_BAR;
    }
    for (;;) {
        const bool has_next = S.next(ui + 1, nxt);
        const char* nA = has_next ? (const char*)g.A + (size_t)nxt.pm * tstep : cA; const char* nB = has_next ? (const char*)g.Bt + (size_t)nxt.pn * tstep : cB;
        for (int t = 0; t < nt; t += 2) {
            const bool last = (t == nt - 2);
            const char* a1 = cA + (size_t)(t + 1) * kstep;
            const char* a2 = last ? nA : cA + (size_t)(t + 2) * kstep; const char* b2 = last ? nB : cB + (size_t)(t + 2) * kstep;
            const char* a3 = a2 + kstep; const char* b3 = b2 + kstep;
            if (last && has_next) S.a_ready(nxt);
            if constexpr (SP2) {
            PG8_LDB(B0, 0, 0); PG8_LDB(B1, 0, 1); PG8_SCHED; PG8_LDA(At, 0, 0); PG8_STAGE(PG8_SA(1, 1), a1 + hstep, voffA);
            PG8_WAIT_V(8); PG8_WAIT_L(0); PG8_BAR; PG8_MMA(0, 0, At, B0); PG8_MMA(0, 1, At, B1); PG8_BAR; PG8_SCHED;
            PG8_LDA(At, 0, 1); PG8_STAGE(PG8_SB(0, 0), b2, voffB); PG8_STAGE(PG8_SB(0, 1), b2 + hstep, voffB); PG8_STAGE(PG8_SA(0, 0), a2, voffA);
            PG8_WAIT_V(8); PG8_WAIT_L(0); PG8_BAR; PG8_MMA(1, 0, At, B0); PG8_MMA(1, 1, At, B1); PG8_BAR; PG8_SCHED;
            PG8_LDB(B0, 1, 0); PG8_LDB(B1, 1, 1); PG8_SCHED; PG8_LDA(At, 1, 0); PG8_STAGE(PG8_SA(0, 1), a2 + hstep, voffA);
            PG8_WAIT_V(8); PG8_WAIT_L(0); PG8_BAR; PG8_MMA(0, 0, At, B0); PG8_MMA(0, 1, At, B1); PG8_BAR; PG8_SCHED;
            PG8_LDA(At, 1, 1); PG8_STAGE(PG8_SB(1, 0), b3, voffB); PG8_STAGE(PG8_SB(1, 1), b3 + hstep, voffB); PG8_STAGE(PG8_SA(1, 0), a3, voffA);
            PG8_WAIT_V(8); PG8_WAIT_L(0); PG8_BAR; PG8_MMA(1, 0, At, B0); PG8_MMA(1, 1, At, B1); PG8_BAR; PG8_SCHED;
            } else {
            PG8_LDB(B0, 0, 0); PG8_SCHED; PG8_LDA(At, 0, 0); PG8_STAGE(PG8_SA(1, 1), a1 + hstep, voffA);
            PG8_WAIT_L(8); PG8_BAR; PG8_WAIT_L(0); PG8_MMA(0, 0, At, B0); PG8_BAR; PG8_SCHED;
            PG8_LDB(B1, 0, 1); PG8_STAGE(PG8_SB(0, 0), b2, voffB);
            PG8_BAR; PG8_WAIT_L(0); PG8_MMA(0, 1, At, B1); PG8_BAR;
            PG8_LDA(At, 0, 1); PG8_STAGE(PG8_SA(0, 0), a2, voffA);
            PG8_BAR; PG8_WAIT_L(0); PG8_MMA(1, 0, At, B0); PG8_BAR; PG8_SCHED;
            PG8_STAGE(PG8_SB(0, 1), b2 + hstep, voffB);
            PG8_WAIT_V(6); PG8_BAR; PG8_MMA(1, 1, At, B1); PG8_BAR;
            PG8_LDB(B0, 1, 0); PG8_SCHED; PG8_LDA(At, 1, 0); PG8_STAGE(PG8_SA(0, 1), a2 + hstep, voffA);
            PG8_WAIT_L(8); PG8_BAR; PG8_WAIT_L(0); PG8_MMA(0, 0, At, B0); PG8_BAR; PG8_SCHED;
            PG8_LDB(B1, 1, 1); PG8_STAGE(PG8_SB(1, 0), b3, voffB);
            PG8_BAR; PG8_WAIT_L(0); PG8_MMA(0, 1, At, B1); PG8_BAR;
            PG8_LDA(At, 1, 1); PG8_STAGE(PG8_SA(1, 0), a3, voffA);
            PG8_BAR; PG8_WAIT_L(0); PG8_MMA(1, 0, At, B0); PG8_BAR; PG8_SCHED;
            PG8_STAGE(PG8_SB(1, 1), b3 + hstep, voffB);
            PG8_WAIT_V(6); PG8_BAR; PG8_MMA(1, 1, At, B1); PG8_BAR;
            }
        }
        if constexpr (ALIGN_EPI) { if (wr == 0) PG8_BAR; }
        if constexpr (!Epi::AFTER_DRAIN) { E(acc, cur, wr, wc, fr, fq); S.done(cur); }
        if (!has_next) break;
#pragma unroll
        for (int a = 0; a < 2; ++a)
#pragma unroll
            for (int b = 0; b < 2; ++b)
#pragma unroll
                for (int m = 0; m < 4; ++m)
#pragma unroll
                    for (int n = 0; n < 2; ++n) acc[a][b][m][n] = (f32x4){0.f, 0.f, 0.f, 0.f};
        cur = nxt; cA = nA; cB = nB; ++ui;
        if constexpr (ALIGN_EPI) { if (wr == 1) PG8_BAR; }
    }
    PG8_WAIT_V(0);
    if constexpr (!ALIGN_EPI) { if (wr == 0) PG8_BAR; }
    PG8_BAR;
    if constexpr (Epi::AFTER_DRAIN) { E.fused(acc, cur, wr, wc, fr, fq, lds, wid, lane); S.done(cur); }
#undef PG8_SA
#undef PG8_SB
#undef PG8_STAGE
#undef PG8_LDA
#undef PG8_LDB
#undef PG8_MMA
#undef PG8_WAIT_V
#undef PG8_WAIT_L
#undef PG8_BAR
#undef PG8_SCHED
}
}

#ifndef PG8_SP2
#define PG8_SP2 true
#endif
#ifndef PG8_ALIGN
#define PG8_ALIGN true
#endif
#include <hip/hip_bf16.h>
#include <cmath>
namespace attn_body {
using bf16=__hip_bfloat16;
using bf16x8=__attribute__((ext_vector_type(8)))short;
using s16x4=__attribute__((ext_vector_type(4)))short;
using f32x16=__attribute__((ext_vector_type(16)))float;
using u32x4=__attribute__((ext_vector_type(4)))unsigned;
constexpr int SEQ=4096,D=64; constexpr int QP=512,KP=512,VP=2560,OP=1024;
constexpr int NW=8,QBLK=32,QB=QBLK*NW,KVBLK=64,NQB=SEQ/QB;
constexpr int ATTN_UNIT_ROWS=QB;
__device__ __forceinline__ int crow(int r,int hi){return (r&3)+8*(r>>2)+4*hi;}
#define SBAR() __builtin_amdgcn_sched_barrier(0)
__device__ __forceinline__ void cmask(f32x16&p0,f32x16&p1,int jb,int qrel,int hi){
  const float NEG=-INFINITY; int kb=64*jb+4*hi;
  #pragma unroll
  for(int r=0;r<16;++r){int kv=kb+(r&3)+8*(r>>2); if(kv>qrel)p0[r]=NEG; if(kv+32>qrel)p1[r]=NEG;}
}

constexpr int NSLOT=3, SLOTB=8192;
constexpr int LDS_K=0, LDS_V=NSLOT*SLOTB, LDS_WS=2*NSLOT*SLOTB, LDS_OST=LDS_WS+NW*64*4, LDS_BYTES=LDS_OST+NW*4096;
constexpr float C2=0.125f*1.4426950408889634f;
__device__ __forceinline__ void glds16(const void*gsrc,unsigned lds_dst){unsigned keep;
  asm volatile("s_mov_b32 %0, m0\n\ts_mov_b32 m0, %2\n\ts_nop 0\n\tglobal_load_lds_dwordx4 %1, off\n\ts_mov_b32 m0, %0":"=&s"(keep):"v"(gsrc),"s"(lds_dst):"memory");}
__device__ __forceinline__ float max3f(float a,float b,float c){float r;asm("v_max3_f32 %0, %1, %2, %3":"=v"(r):"v"(a),"v"(b),"v"(c));return r;}
__device__ __forceinline__ float max2f(float a,float b){float r;asm("v_max_f32_e32 %0, %1, %2":"=v"(r):"v"(a),"v"(b));return r;}
__device__ __forceinline__ float fadd_s(float a,float b){float r;asm("v_add_f32_e32 %0, %1, %2":"=v"(r):"v"(a),"v"(b));return r;}
__device__ __forceinline__ float fsub_s(float a,float b){float r;asm("v_sub_f32_e32 %0, %1, %2":"=v"(r):"v"(a),"v"(b));return r;}
typedef float f32x2_t __attribute__((ext_vector_type(2))); typedef __bf16 bf16x2_t __attribute__((ext_vector_type(2)));
__device__ __forceinline__ unsigned cvtpk_s(float lo,float hi){f32x2_t v={lo,hi};bf16x2_t b=__builtin_convertvector(v,bf16x2_t);return __builtin_bit_cast(unsigned,b);}
#define WAIT_BAR(N) asm volatile("s_waitcnt vmcnt(" #N ") lgkmcnt(0)\n\ts_barrier":::"memory")

__device__ __forceinline__ void qkt(f32x16&p0,f32x16&p1,const char*Kslot,const bf16x8*qr,const f32x16&negm,int r32,int hi){
  const char*kb=Kslot+hi*1024+r32*16;
  #pragma unroll
  for(int d0=0;d0<4;++d0){
    const bf16x8 b0=*reinterpret_cast<const bf16x8*>(kb+d0*2048);
    const bf16x8 b1=*reinterpret_cast<const bf16x8*>(kb+d0*2048+512);
    if(d0==0){p0=__builtin_amdgcn_mfma_f32_32x32x16_bf16(b0,qr[0],negm,0,0,0);p1=__builtin_amdgcn_mfma_f32_32x32x16_bf16(b1,qr[0],negm,0,0,0);}
    else{p0=__builtin_amdgcn_mfma_f32_32x32x16_bf16(b0,qr[d0],p0,0,0,0);p1=__builtin_amdgcn_mfma_f32_32x32x16_bf16(b1,qr[d0],p1,0,0,0);}}
}
typedef __attribute__((address_space(3))) const char* lds_cptr;
typedef short v4i16_t __attribute__((ext_vector_type(4)));
__device__ __forceinline__ void kload8(bf16x8*kf,lds_cptr kp){
  kf[0]=*(const __attribute__((address_space(3))) bf16x8*)(kp);      kf[1]=*(const __attribute__((address_space(3))) bf16x8*)(kp+512);
  kf[2]=*(const __attribute__((address_space(3))) bf16x8*)(kp+2048); kf[3]=*(const __attribute__((address_space(3))) bf16x8*)(kp+2560);
  kf[4]=*(const __attribute__((address_space(3))) bf16x8*)(kp+4096); kf[5]=*(const __attribute__((address_space(3))) bf16x8*)(kp+4608);
  kf[6]=*(const __attribute__((address_space(3))) bf16x8*)(kp+6144); kf[7]=*(const __attribute__((address_space(3))) bf16x8*)(kp+6656);
}
__device__ __forceinline__ void kload2(bf16x8*kf,lds_cptr kp,int j){ kf[2*j]=*(const __attribute__((address_space(3))) bf16x8*)(kp+j*2048); kf[2*j+1]=*(const __attribute__((address_space(3))) bf16x8*)(kp+j*2048+512); }
__device__ __forceinline__ s16x4 vtr(lds_cptr p){ return __builtin_bit_cast(s16x4,__builtin_amdgcn_ds_read_tr16_b64_v4i16((__attribute__((address_space(3))) v4i16_t*)p)); }
__device__ __forceinline__ float rowmax(const f32x16&p0,const f32x16&p1){
  float a=max3f(p0[0],p0[1],p1[0]),b=max3f(p0[2],p0[3],p1[1]);a=max3f(a,p1[2],p1[3]);
  #pragma unroll
  for(int r=4;r<16;r+=4){a=max3f(a,p0[r],p0[r+1]);b=max3f(b,p0[r+2],p0[r+3]);a=max3f(a,p1[r],p1[r+1]);b=max3f(b,p1[r+2],p1[r+3]);}
  const float m=max2f(a,b);
  auto rr=__builtin_amdgcn_permlane32_swap(__float_as_uint(m),__float_as_uint(m),false,false);
  return max2f(__uint_as_float(rr[0]),__uint_as_float(rr[1]));
}
__device__ __forceinline__ void pv(f32x16*o,int vb,bf16x8 pa0,bf16x8 pa1,bf16x8 pa2,bf16x8 pa3){
  #pragma unroll
  for(int d0=0;d0<2;++d0){s16x4 lo[4],hi[4];
    #pragma unroll
    for(int ks=0;ks<4;++ks){
      asm volatile("ds_read_b64_tr_b16 %0,%1 offset:%c2":"=&v"(lo[ks]):"v"(vb),"i"(d0*4096+ks*1024):"memory");
      asm volatile("ds_read_b64_tr_b16 %0,%1 offset:%c2":"=&v"(hi[ks]):"v"(vb),"i"(d0*4096+ks*1024+512):"memory");}
    asm volatile("s_waitcnt lgkmcnt(0)":::"memory");SBAR();
    #define PK(k) (bf16x8){lo[k][0],lo[k][1],lo[k][2],lo[k][3],hi[k][0],hi[k][1],hi[k][2],hi[k][3]}
    o[d0]=__builtin_amdgcn_mfma_f32_32x32x16_bf16(pa0,PK(0),o[d0],0,0,0);
    o[d0]=__builtin_amdgcn_mfma_f32_32x32x16_bf16(pa1,PK(1),o[d0],0,0,0);
    o[d0]=__builtin_amdgcn_mfma_f32_32x32x16_bf16(pa2,PK(2),o[d0],0,0,0);
    o[d0]=__builtin_amdgcn_mfma_f32_32x32x16_bf16(pa3,PK(3),o[d0],0,0,0);
    #undef PK
  }
}

#ifndef ATTN_STORE16
#define ATTN_STORE16(p,v) (*(u32x4*)(p)=(v))
#endif
template<int THRL> __device__ __forceinline__ void attn_unit(int b,int qb,const bf16*Q,const bf16*__restrict__ K,const bf16*__restrict__ V,bf16*O,char*shm){
  int tid_=threadIdx.x; asm volatile("":"+v"(tid_)); const int tid=tid_,lane=tid&63,r32=lane&31,hi=lane>>5; const int wid=__builtin_amdgcn_readfirstlane(tid>>6);
  const long rowbase=(long)b*SEQ; const int q0=qb*QB;
  const bf16*Qw=Q+(rowbase+q0+wid*QBLK)*QP;
  const bf16*Kh=K+rowbase*KP,*Vh=V+rowbase*VP;
  const unsigned lds0=(unsigned)(uintptr_t)shm;
  float*wsf=(float*)(shm+LDS_WS)+wid*64;
  const bf16*ksrc=Kh+(long)lane*KP+wid*8;
  const bf16*vsrc=Vh+(long)(16*(wid&3)+(lane>>2))*VP+(wid>>2)*32+(lane&3)*8;
  const unsigned kdst=lds0+LDS_K+wid*1024, vdst=lds0+LDS_V+wid*1024;
  #define DMA_K(t,slot) glds16(ksrc+(long)(t)*KVBLK*KP,(unsigned)__builtin_amdgcn_readfirstlane(kdst+(slot)))
  #define DMA_V(t,slot) glds16(vsrc+(long)(t)*KVBLK*VP,(unsigned)__builtin_amdgcn_readfirstlane(vdst+(slot)))
  const int vb0=(int)(lds0+LDS_V)+((lane>>4)&1)*32+(lane&3)*8+(4*hi+((lane&15)>>2))*64;
  const char*Kbase=shm+LDS_K; bf16x8 kf[8];
  const lds_cptr shm3=(lds_cptr)shm; const lds_cptr kp0=shm3+LDS_K+hi*1024+r32*16; const lds_cptr vp0=shm3+LDS_V+((lane>>4)&1)*32+(lane&3)*8+(4*hi+((lane&15)>>2))*64;
  const int NT=(q0+QB)/KVBLK;
  DMA_K(0,0);DMA_V(0,0);DMA_K(1,SLOTB);
  bf16x8 qr[4];
  #pragma unroll
  for(int d0=0;d0<4;++d0)qr[d0]=*reinterpret_cast<const bf16x8*>(&Qw[(long)r32*QP+d0*16+hi*8]);
  float mhat=0.f,l_reg=0.f;f32x16 o[2];f32x16 negm; { float z_=0.f; asm volatile("":"+v"(z_)); _Pragma("unroll") for(int r=0;r<16;++r){o[0][r]=z_;o[1][r]=z_;negm[r]=z_;} } asm volatile("":"+v"(negm));
  const int qrel=wid*QBLK+r32;
  #define CMASK(P0,P1,t) do{int jb_=(t)-(NT-4); if(jb_>=0)cmask(P0,P1,jb_,qrel,hi);}while(0)
  bool resc=false;
  #define START(P0,P1) do{ const float rm=rowmax(P0,P1); resc=false; \
    { const float dl=rm; mhat=fadd_s(mhat,dl); \
      _Pragma("unroll") for(int r=0;r<16;++r){P0[r]=fsub_s(P0[r],dl);P1[r]=fsub_s(P1[r],dl);} \
      _Pragma("unroll") for(int r=0;r<16;++r)negm[r]=-mhat; asm volatile("":"+v"(negm)); } \
    _Pragma("unroll") for(int r=0;r<16;++r)P0[r]=__builtin_amdgcn_exp2f(P0[r]); }while(0)
  #define RESC() do{ if(resc){ asm volatile("s_waitcnt lgkmcnt(0)":::"memory"); \
      _Pragma("unroll") for(int d_=0;d_<2;++d_) _Pragma("unroll") for(int r=0;r<16;++r)o[d_][r]*=wsf[crow(r,hi)]; } }while(0)
  f32x16 pA0,pA1,pB0,pB1;
  int sl_prev=0,sl_cur=0,sl_next=SLOTB;
  #define ROT() do{sl_prev=sl_cur;sl_cur=sl_next;sl_next=(sl_next==(NSLOT-1)*SLOTB)?0:sl_next+SLOTB;}while(0)
  DMA_K(2,2*SLOTB);
  WAIT_BAR(3);
  qkt(pA0,pA1,Kbase,qr,negm,r32,hi);asm volatile("s_nop 15\n\ts_nop 7":"+v"(pA0),"+v"(pA1));CMASK(pA0,pA1,0);
  START(pA0,pA1);
  _Pragma("unroll") for(int r=0;r<16;++r)pA1[r]=__builtin_amdgcn_exp2f(pA1[r]);
  WAIT_BAR(0);
  DMA_K(3,0);DMA_V(1,SLOTB);
  ROT();
  kload8(kf,kp0+sl_cur);
  WAIT_BAR(2);
  s16x4 vlo[8],vhi[8]; u32x4 pw0,pw1,pw2,pw3;
  #define PKW(P,B) cvtpk_s(P[B],P[B+1])
  #define PAF(k) __builtin_bit_cast(bf16x8,pw##k)
  #define VFR(i) (bf16x8){vlo[i][0],vlo[i][1],vlo[i][2],vlo[i][3],vhi[i][0],vhi[i][1],vhi[i][2],vhi[i][3]}
  #define PIN(x) asm volatile("":"+v"(x))
  #define MX3(a,b,c) __builtin_fmaxf(__builtin_fmaxf((a),(b)),(c))
  #define GAPA(MF,A0,A1,A2,A3,W0,W1,PW) do{ MF; sacc+=A0; sacc+=A1; sacc+=A2; sacc+=A3; PIN(sacc); W0; W1; PIN(PW); SBAR(); }while(0)
  #define EX(v) __builtin_amdgcn_exp2f(v)
  #define GAPB(MF,X,B) do{ MF; X[B]=EX(X[B]); X[B+1]=EX(X[B+1]); X[B+2]=EX(X[B+2]); X[B+3]=EX(X[B+3]); PIN(X); SBAR(); }while(0)
  #define VRD(i) do{ vlo[i]=vtr(vp_+(((i)>>2)*4096+((i)&3)*1024)); vhi[i]=vtr(vp_+(((i)>>2)*4096+((i)&3)*1024+512)); }while(0)
  #define KRD(G,j) do{ if(G){ kload2(kf,kp0+sl_next,j); SBAR(); } }while(0)
  #define STEP(C0,C1,P0,P1,t,GK,GV,GL) do{ SBAR(); \
    const lds_cptr vp_=vp0+sl_prev; \
    VRD(0); SBAR(); float sacc=(P0[0]+P0[1]); \
    GAPA(C0=__builtin_amdgcn_mfma_f32_32x32x16_bf16(kf[0],qr[0],negm,0,0,0), P0[2],P0[3],P0[4],P0[5],     pw0[0]=PKW(P0,0), pw0[1]=PKW(P0,2), pw0); \
    VRD(4); SBAR(); GAPA(C1=__builtin_amdgcn_mfma_f32_32x32x16_bf16(kf[1],qr[0],negm,0,0,0), P0[6],P0[7],P0[8],P0[9],     pw0[2]=PKW(P0,4), pw0[3]=PKW(P0,6), pw0); \
    VRD(1); SBAR(); GAPA(C0=__builtin_amdgcn_mfma_f32_32x32x16_bf16(kf[2],qr[1],C0,0,0,0),   P0[10],P0[11],P0[12],P0[13], pw1[0]=PKW(P0,8), pw1[1]=PKW(P0,10), pw1); \
    VRD(5); SBAR(); GAPA(C1=__builtin_amdgcn_mfma_f32_32x32x16_bf16(kf[3],qr[1],C1,0,0,0),   P0[14],P0[15],P1[0],P1[1],   pw1[2]=PKW(P0,12),pw1[3]=PKW(P0,14), pw1); \
    VRD(2); SBAR(); GAPA(C0=__builtin_amdgcn_mfma_f32_32x32x16_bf16(kf[4],qr[2],C0,0,0,0),   P1[2],P1[3],P1[4],P1[5],     pw2[0]=PKW(P1,0), pw2[1]=PKW(P1,2), pw2); \
    VRD(6); SBAR(); GAPA(C1=__builtin_amdgcn_mfma_f32_32x32x16_bf16(kf[5],qr[2],C1,0,0,0),   P1[6],P1[7],P1[8],P1[9],     pw2[2]=PKW(P1,4), pw2[3]=PKW(P1,6), pw2); \
    VRD(3); SBAR(); GAPA(C0=__builtin_amdgcn_mfma_f32_32x32x16_bf16(kf[6],qr[3],C0,0,0,0),   P1[10],P1[11],P1[12],P1[13], pw3[0]=PKW(P1,8), pw3[1]=PKW(P1,10), pw3); \
    VRD(7); SBAR(); GAPA(C1=__builtin_amdgcn_mfma_f32_32x32x16_bf16(kf[7],qr[3],C1,0,0,0),   P1[14],P1[15],0.f,0.f,       pw3[2]=PKW(P1,12),pw3[3]=PKW(P1,14), pw3); \
    l_reg+=sacc; \
    if(GK){DMA_K((t)+3,sl_cur);} if(GV){DMA_V((t)+1,sl_next);} \
    CMASK(C0,C1,t); \
    { float a=MX3(C0[0],C0[1],C1[0]),b=MX3(C0[2],C0[3],C1[1]); a=MX3(a,C1[2],C1[3]); \
      _Pragma("unroll") for(int r=4;r<16;r+=4){a=MX3(a,C0[r],C0[r+1]);b=MX3(b,C0[r+2],C0[r+3]);a=MX3(a,C1[r],C1[r+1]);b=MX3(b,C1[r+2],C1[r+3]);} \
      float rm=__builtin_fmaxf(a,b); { auto rr=__builtin_amdgcn_permlane32_swap(__float_as_uint(rm),__float_as_uint(rm),false,false); rm=__builtin_fmaxf(__uint_as_float(rr[0]),__uint_as_float(rr[1])); } \
      resc=false; \
      if(__builtin_expect(__any(rm>(float)THRL),0)){ const float dl=__builtin_fmaxf(rm,0.f); mhat+=dl; \
        _Pragma("unroll") for(int r=0;r<16;++r){C0[r]-=dl;C1[r]-=dl;} \
        _Pragma("unroll") for(int r=0;r<16;++r)negm[r]=-mhat; asm volatile("":"+v"(negm)); \
        const float f=__builtin_amdgcn_exp2f(-dl); l_reg*=f; if(hi==0)wsf[r32]=f; resc=true; } } \
    SBAR(); \
    GAPB(o[0]=__builtin_amdgcn_mfma_f32_32x32x16_bf16(PAF(0),VFR(0),o[0],0,0,0), C0,0); \
    GAPB(o[1]=__builtin_amdgcn_mfma_f32_32x32x16_bf16(PAF(0),VFR(4),o[1],0,0,0), C0,4); \
    KRD(GL,0); GAPB(o[0]=__builtin_amdgcn_mfma_f32_32x32x16_bf16(PAF(1),VFR(1),o[0],0,0,0), C0,8); \
    KRD(GL,1); GAPB(o[1]=__builtin_amdgcn_mfma_f32_32x32x16_bf16(PAF(1),VFR(5),o[1],0,0,0), C0,12); \
    KRD(GL,2); GAPB(o[0]=__builtin_amdgcn_mfma_f32_32x32x16_bf16(PAF(2),VFR(2),o[0],0,0,0), C1,0); \
    KRD(GL,3); GAPB(o[1]=__builtin_amdgcn_mfma_f32_32x32x16_bf16(PAF(2),VFR(6),o[1],0,0,0), C1,4); \
    GAPB(o[0]=__builtin_amdgcn_mfma_f32_32x32x16_bf16(PAF(3),VFR(3),o[0],0,0,0), C1,8); \
    GAPB(o[1]=__builtin_amdgcn_mfma_f32_32x32x16_bf16(PAF(3),VFR(7),o[1],0,0,0), C1,12); \
    }while(0)
  int t=1;
  #undef CMASK
  #define CMASK(P0,P1,t) do{}while(0)
  for(;t+5<NT;t+=2){
    STEP(pB0,pB1,pA0,pA1,t,true,true,true);     WAIT_BAR(2); RESC(); ROT();
    STEP(pA0,pA1,pB0,pB1,t+1,true,true,true);   WAIT_BAR(2); RESC(); ROT();
  }
  #undef CMASK
  #define CMASK(P0,P1,t) do{int jb_=(t)-(NT-4); if(jb_>=0)cmask(P0,P1,jb_,qrel,hi);}while(0)
  #define ENDW(tt) do{ if((tt)+3<NT){WAIT_BAR(2);} else if((tt)+2<NT){WAIT_BAR(1);} else {WAIT_BAR(0);} }while(0)
  for(;t+1<NT;t+=2){
    STEP(pB0,pB1,pA0,pA1,t,(t+3<NT),(t+1<NT),(t+1<NT));       ENDW(t);   RESC(); ROT();
    STEP(pA0,pA1,pB0,pB1,t+1,(t+4<NT),(t+2<NT),(t+2<NT));     ENDW(t+1); RESC(); ROT();
  }
  STEP(pB0,pB1,pA0,pA1,NT-1,false,false,false); RESC();
  { float sacc=pB0[0]+pB0[1]; _Pragma("unroll") for(int r=2;r<16;++r)sacc+=pB0[r]; _Pragma("unroll") for(int r=0;r<16;++r)sacc+=pB1[r]; l_reg+=sacc;
    pw0=(u32x4){PKW(pB0,0),PKW(pB0,2),PKW(pB0,4),PKW(pB0,6)};pw1=(u32x4){PKW(pB0,8),PKW(pB0,10),PKW(pB0,12),PKW(pB0,14)};pw2=(u32x4){PKW(pB1,0),PKW(pB1,2),PKW(pB1,4),PKW(pB1,6)};pw3=(u32x4){PKW(pB1,8),PKW(pB1,10),PKW(pB1,12),PKW(pB1,14)};
    SBAR(); pv(o,vb0+sl_cur,PAF(0),PAF(1),PAF(2),PAF(3)); }
  #undef PKW
  #undef PAF
  #undef VFR
  #undef PIN
  #undef MX3
  #undef GAPA
  #undef GAPB
  #undef EX
  #undef VRD
  #undef KRD
  #undef STEP
  #undef ENDW
  {auto rr=__builtin_amdgcn_permlane32_swap(__float_as_uint(l_reg),__float_as_uint(l_reg),false,false);l_reg=__uint_as_float(rr[0])+__uint_as_float(rr[1]);}
  if(hi==0)wsf[32+r32]=l_reg;asm volatile("s_waitcnt lgkmcnt(0)":::"memory");
  float rli[16];
  #pragma unroll
  for(int r=0;r<16;++r)rli[r]=__builtin_amdgcn_rcpf(wsf[32+crow(r,hi)]);
  bf16*Ow=O+(rowbase+q0+wid*QBLK)*OP;
  { bf16*stg=(bf16*)(shm+LDS_OST)+wid*2048;
    #pragma unroll
    for(int r=0;r<16;++r){const int orow=crow(r,hi);
      #pragma unroll
      for(int d0=0;d0<2;++d0)stg[orow*64+d0*32+r32]=__float2bfloat16(o[d0][r]*rli[r]);}
    asm volatile("s_waitcnt lgkmcnt(0)":::"memory");
    #pragma unroll
    for(int i=0;i<4;++i){const int row=i*8+(lane>>3),ch=lane&7; const u32x4 v=*(const u32x4*)(stg+row*64+ch*8); ATTN_STORE16(Ow+(long)row*OP+ch*8,v);} }
  asm volatile("s_waitcnt lgkmcnt(0)\n\ts_barrier":::"memory");
  #undef DMA_K
  #undef DMA_V
  #undef CMASK
  #undef START
  #undef RESC
  #undef ROT
}
constexpr int ATTN_LDS_BYTES=LDS_BYTES;
#undef SBAR
#undef WAIT_BAR
}
#define GAS __attribute__((address_space(1)))
#define LAS __attribute__((address_space(3)))
typedef unsigned short bf16;
typedef unsigned v4u __attribute__((ext_vector_type(4)));
typedef float f32x4 __attribute__((ext_vector_type(4)));
typedef short bf16x8 __attribute__((ext_vector_type(8)));
typedef GAS unsigned gu32;
typedef GAS unsigned long long gu64;
#define RLX_AGENT __ATOMIC_RELAXED, __HIP_MEMORY_SCOPE_AGENT
#define LDS_WAIT() asm volatile("s_waitcnt lgkmcnt(0)" ::: "memory")
#define VM_WAIT() asm volatile("s_waitcnt vmcnt(0)" ::: "memory")
__device__ __forceinline__ unsigned long long rt() { return __builtin_amdgcn_s_memrealtime(); }
__device__ __forceinline__ unsigned f2bf(float f) { unsigned u = __builtin_bit_cast(unsigned, f); return (u + 0x7fffu + ((u >> 16) & 1u)) >> 16; }
__device__ __forceinline__ unsigned pk2(float lo, float hi) { return f2bf(lo) | (f2bf(hi) << 16); }

#define XB_TMO      128
#define XB_XCNT(j)  (256  + 64 * (j))
#define XB_XSUB(j)  (1280 + 64 * (j))
#define XB_XGEN(j)  (2304 + 64 * (j))
#define XB_TOP      3328
#define XB_TOPGEN   3392
#define XCD_BAR_WORDS 3456
#define XB_SPIN_CAP (1u << 18)

__device__ __forceinline__ unsigned xb_ld(unsigned* p)              { return __hip_atomic_load(p, __ATOMIC_RELAXED, __HIP_MEMORY_SCOPE_AGENT); }
__device__ __forceinline__ unsigned xb_add(unsigned* p, unsigned v) { return __hip_atomic_fetch_add(p, v, __ATOMIC_RELAXED, __HIP_MEMORY_SCOPE_AGENT); }
__device__ __forceinline__ unsigned xb_xcc_id() { return (unsigned)__builtin_amdgcn_s_getreg((3 << 11) | 20) & 0xFu; }
#define XB_SPIN(cond, bar) do { unsigned _sp = 0; while (cond) { __builtin_amdgcn_s_sleep(1); \
    if ((++_sp & 255u) == 0u) { if (xb_ld(&(bar)[XB_TMO])) break; if (_sp > XB_SPIN_CAP) { atomicAdd(&(bar)[XB_TMO], 1u); break; } } } } while (0)

struct XcdBarrier {
    unsigned* bar; unsigned x;
    volatile LAS unsigned* st;
};

__device__ __forceinline__ XcdBarrier xcd_barrier_post(unsigned* bar, volatile LAS unsigned* st) {
    XcdBarrier b; b.bar = bar; b.x = xb_xcc_id(); b.st = st;
    if (threadIdx.x == 0) (void)xb_add(&bar[XB_XCNT(b.x)], 1u);
    return b;
}
__device__ __forceinline__ void xcd_barrier_complete(unsigned* bar, unsigned x, unsigned& nloc, unsigned& nx) {
    const unsigned G = gridDim.x * gridDim.y * gridDim.z;
    unsigned sum, cnt, mine, sp = 0u;
    for (;;) {
        sum = 0u; cnt = 0u; mine = 0u;
#pragma unroll
        for (unsigned j = 0; j < 16; ++j) { const unsigned c = xb_ld(&bar[XB_XCNT(j)]); sum += c; cnt += (c > 0u) ? 1u : 0u; mine = (j == x) ? c : mine; }
        if (sum == G) break;
        __builtin_amdgcn_s_sleep(1);
        if ((++sp & 255u) == 0u) { if (xb_ld(&bar[XB_TMO])) break; if (sp > XB_SPIN_CAP) { atomicAdd(&bar[XB_TMO], 1u); break; } }
    }
    nloc = mine > 0u ? mine : 1u; nx = cnt > 0u ? cnt : 1u;
}

__device__ __forceinline__ void xcd_barrier(const XcdBarrier& b) {
    asm volatile("s_waitcnt vmcnt(0)" ::: "memory");
    __syncthreads();
    if (threadIdx.x == 0) {
        unsigned* bar = b.bar;
        __builtin_amdgcn_s_waitcnt(0);
        unsigned nloc = b.st[0], nx = b.st[1];
        if (nloc == 0u) { xcd_barrier_complete(bar, b.x, nloc, nx); b.st[0] = nloc; b.st[1] = nx; }
        const unsigned old = xb_add(&bar[XB_XSUB(b.x)], 1u);
        const unsigned gen = old / nloc;
        if (old + 1u == (gen + 1u) * nloc) {
            __builtin_amdgcn_fence(__ATOMIC_RELEASE, "agent");
            asm volatile("s_waitcnt vmcnt(0)" ::: "memory");
            const unsigned og = xb_add(&bar[XB_TOP], 1u);
            const unsigned tg = og / nx;
            if (og + 1u == (tg + 1u) * nx) xb_add(&bar[XB_TOPGEN], 1u);
            else XB_SPIN(xb_ld(&bar[XB_TOPGEN]) == tg, bar);
            __builtin_amdgcn_fence(__ATOMIC_ACQUIRE, "agent");
            xb_add(&bar[XB_XGEN(b.x)], 1u);
            asm volatile("s_waitcnt vmcnt(0)" ::: "memory");
        } else {
            XB_SPIN(xb_ld(&bar[XB_XGEN(b.x)]) == gen, bar);
            __builtin_amdgcn_fence(__ATOMIC_ACQUIRE, "agent");
            asm volatile("s_waitcnt vmcnt(0)" ::: "memory");
        }
    }
    __syncthreads();
}

constexpr int NWAVES = 8;
constexpr int DM = 1024, NB = 4, SEQ = 4096, MP = NB * SEQ, DB = 128, DT = 4, MS = DB * DT, MA = MP + MS;
constexpr int NIN = 2560, NUP = 5632, DFF = 2816, NADA = 6144, PAST = 2048;
constexpr float EPS = 1e-6f, LAM0 = 0.2f;
constexpr float C2 = attn_body::C2;
static_assert(MP == pg8::MPROMPT, "row split");
constexpr size_t O_YP = 0, O_YS = 16777216, O_KP = 17301504, O_VP = 25690112, O_LCP = 34078720, O_LHP = 34084864, O_FCP = 34086912,
                 O_KS = 34131968, O_VS = 34394112, O_LCS = 34656256, O_LHS = 34852864, O_FCS = 34918400, O_END = 36360192;
constexpr size_t MiB = 1u << 20;
constexpr size_t WS_CTL = 0, CTL_ZERO_BYTES = 1 * MiB;
constexpr size_t WS_WADA = 2 * MiB, WS_WIN = 14 * MiB, WS_WOUT = 19 * MiB, WS_WUP = 21 * MiB, WS_WDN = 32 * MiB;
constexpr size_t WS_SC = 38 * MiB, WS_MOD = 39 * MiB, WS_ROPE = 45 * MiB, WS_SEGA = 46 * MiB, WS_SEGB = 46 * MiB + 512 * 1024;
constexpr size_t WS_XN = 48 * MiB, WS_PROJ = 81 * MiB, WS_QB = 164 * MiB, WS_KB = 181 * MiB, WS_OB = 198 * MiB, WS_HL = 230 * MiB, WS_CA = 247 * MiB;
constexpr size_t WS_EDGE = 636 * MiB;
constexpr size_t WS_MIX = 264 * MiB, WS_X1 = 297 * MiB, WS_UP = 363 * MiB, WS_ACT = 545 * MiB, WS_END = 640 * MiB;
constexpr int CW_BAR = 4096, CW_Q = 8192;

constexpr int RING_OFF = 0, RING_BYTES = 131072, EXTRA_BYTES = 1024;
constexpr int LDSCTL_OFF = RING_BYTES + EXTRA_BYTES, MISC_OFF = LDSCTL_OFF + 320;
constexpr int HTAB_OFF = MISC_OFF + 128;
constexpr int LDS_BYTES = 147456;
static_assert(HTAB_OFF % 16 == 0 && HTAB_OFF + 8192 <= LDS_BYTES, "LDS map");
static_assert(MISC_OFF + 128 <= LDS_BYTES, "LDS map");

typedef unsigned u32x2v __attribute__((ext_vector_type(2)));
typedef float f32x2v __attribute__((ext_vector_type(2)));

typedef const unsigned long long __attribute__((address_space(4)))* KIN;
struct Frame {
    LAS unsigned char* lds;
    volatile LAS unsigned* MISC;
    gu32* ctl;
    int tid, lane, wave, vcu, G;
    KIN kin; unsigned char* ws; float* out;
    __device__ __forceinline__ const float* inp(int k) const { return (const float*)(const GAS float*)kin[k]; }
};

__device__ __forceinline__ float wave_sum(float v) {
#pragma unroll
    for (int o = 1; o < 64; o <<= 1) v += __shfl_xor(v, o);
    return v;
}
__device__ __forceinline__ float bflo(unsigned w) { return __uint_as_float(w << 16); }
__device__ __forceinline__ float bfhi(unsigned w) { return __uint_as_float(w & 0xffff0000u); }
__device__ __forceinline__ void unpack8(const v4u r, float (&f)[8]) {
    f[0] = bflo(r.x); f[1] = bfhi(r.x); f[2] = bflo(r.y); f[3] = bfhi(r.y); f[4] = bflo(r.z); f[5] = bfhi(r.z); f[6] = bflo(r.w); f[7] = bfhi(r.w);
}
__device__ __forceinline__ v4u pack8(const float (&f)[8]) {
    v4u o; o.x = pg8::cvt_pk_bf16(f[0], f[1]); o.y = pg8::cvt_pk_bf16(f[2], f[3]); o.z = pg8::cvt_pk_bf16(f[4], f[5]); o.w = pg8::cvt_pk_bf16(f[6], f[7]); return o;
}
__device__ __forceinline__ float sigmoidf_(float x) { return 1.0f / (1.0f + __expf(-x)); }
__device__ __forceinline__ float gelu_tanh(float x) {
    const float u = 0.7978845608028654f * (x + 0.044715f * x * x * x);
    const float t = 1.0f - 2.0f / (1.0f + __expf(2.0f * u));
    return 0.5f * x * (1.0f + t);
}
__device__ __forceinline__ int mod_row(int m) { return (m < MP) ? (m >> 12) : 4 + ((m - MP) >> 2); }

__device__ __forceinline__ void p0_transpose_item(const float* W, int K, int N, bf16* WT, int row_off, LAS float* scr, int item, int lane, bool perm_up = false) {
    const int nblk = N / 32, kb = item / nblk, nb = item % nblk, k0 = 64 * kb, n0 = 32 * nb;
    const int d0 = !perm_up ? row_off + n0 : (n0 < DFF ? 256 * (n0 / 128) + (n0 % 128) : 256 * ((n0 - DFF) / 128) + 128 + ((n0 - DFF) % 128));
#pragma unroll 8
    for (int i = 0; i < 32; ++i) { const int kk = 2 * i + (lane >> 5); scr[kk * 33 + (lane & 31)] = W[(size_t)(k0 + kk) * N + n0 + (lane & 31)]; }
    LDS_WAIT(); asm volatile("" ::: "memory");
    const int c = lane & 7;
#pragma unroll
    for (int j = 0; j < 4; ++j) { const int n = (lane >> 3) + 8 * j; const LAS float* s = scr + (8 * c) * 33 + n;
        v4u o; o.x = pk2(s[0 * 33], s[1 * 33]); o.y = pk2(s[2 * 33], s[3 * 33]); o.z = pk2(s[4 * 33], s[5 * 33]); o.w = pk2(s[6 * 33], s[7 * 33]);
        *(GAS v4u*)(WT + (size_t)(d0 + n) * K + k0 + 8 * c) = o; }
    LDS_WAIT(); asm volatile("" ::: "memory");
}
__device__ __forceinline__ void p0_prologue(Frame& F) {
    LAS float* scr = (LAS float*)(F.lds + RING_OFF + F.wave * 16384);
    const int gw = F.vcu * NWAVES + F.wave, NGW = F.G * NWAVES;
    constexpr int I_ADA = (DM / 64) * (NADA / 32), I_IN = (DM / 64) * (NIN / 32), I_OUT = (DM / 64) * (DM / 32), I_UP = (DM / 64) * (NUP / 32), I_DN = (DFF / 64) * (DM / 32);
    constexpr int NITEMS = I_ADA + I_IN + I_OUT + I_UP + I_DN;
    for (int it = gw; it < NITEMS; it += NGW) {
        int r = it;
        if (r < I_ADA) { p0_transpose_item(F.inp(12), DM, NADA, ((bf16*)(F.ws + WS_WADA)), 0, scr, r, F.lane); continue; } r -= I_ADA;
        if (r < I_IN) { p0_transpose_item(F.inp(14), DM, NIN, ((bf16*)(F.ws + WS_WIN)), 0, scr, r, F.lane); continue; } r -= I_IN;
        if (r < I_OUT) { p0_transpose_item(F.inp(22), DM, DM, ((bf16*)(F.ws + WS_WOUT)), 0, scr, r, F.lane); continue; } r -= I_OUT;
        if (r < I_UP) { p0_transpose_item(F.inp(30), DM, NUP, ((bf16*)(F.ws + WS_WUP)), 0, scr, r, F.lane, true); continue; } r -= I_UP;
        p0_transpose_item(F.inp(33), DFF, DM, ((bf16*)(F.ws + WS_WDN)), 0, scr, r, F.lane);
    }
    for (int r = gw; r < 256; r += NGW) {
        const float* src = (r < 4) ? F.inp(8) + (size_t)r * DM : F.inp(9) + (size_t)(r < 132 ? r - 4 : 0) * DM;
#pragma unroll
        for (int j = 0; j < 4; ++j) { const int c = 4 * F.lane + 256 * j; f32x4 v = *(const f32x4*)(src + c);
            if (r >= 132) v = (f32x4){0.f, 0.f, 0.f, 0.f};
            f32x4 s; s.x = v.x / (1.0f + __expf(-v.x)); s.y = v.y / (1.0f + __expf(-v.y)); s.z = v.z / (1.0f + __expf(-v.z)); s.w = v.w / (1.0f + __expf(-v.w));
            u32x2v o; o.x = pk2(s.x, s.y); o.y = pk2(s.z, s.w); *(u32x2v*)(((bf16*)(F.ws + WS_SC)) + (size_t)r * DM + c) = o; }
    }
    for (int e = gw * 64 + F.lane; e < SEQ * 8; e += NGW * 64) {
        const int pos = e >> 3, j = e & 7;
        const float freq = powf(500000.0f, -(float)j * 0.125f);
        const float ang = (float)pos * freq;
        ((float*)(F.ws + WS_ROPE))[2 * e] = cosf(ang); ((float*)(F.ws + WS_ROPE))[2 * e + 1] = sinf(ang);
    }
}

__device__ __forceinline__ void norm_mod_rows(Frame& F, const float* bp, const float* bs, const float* gn, int sc_off, int sh_off) {
    const int gw = F.vcu * NWAVES + F.wave, NGW = F.G * NWAVES;
    for (int mb = gw; mb < MA; mb += 2 * NGW) {
        const int m2 = mb + NGW; const bool has2 = (m2 < MA); const int mm[2] = {mb, has2 ? m2 : mb};
        f32x4 v[2][4]; float ss[2] = {0.f, 0.f};
#pragma unroll
        for (int r = 0; r < 2; ++r) { const int m = mm[r]; const float* xr = (m < MP) ? bp + (size_t)m * DM : bs + (size_t)(m - MP) * DM;
#pragma unroll
            for (int j = 0; j < 4; ++j) v[r][j] = *(const f32x4*)(xr + 4 * F.lane + 256 * j); }
#pragma unroll
        for (int r = 0; r < 2; ++r)
#pragma unroll
            for (int j = 0; j < 4; ++j) ss[r] += (v[r][j].x * v[r][j].x + v[r][j].y * v[r][j].y) + (v[r][j].z * v[r][j].z + v[r][j].w * v[r][j].w);
#pragma unroll
        for (int r = 0; r < 2; ++r) { if (r == 1 && !has2) break;
            const int m = mm[r]; const float* md = ((float*)(F.ws + WS_MOD)) + (size_t)mod_row(m) * NADA;
            const float rstd = rsqrtf(wave_sum(ss[r]) * (1.0f / DM) + EPS);
#pragma unroll
            for (int j = 0; j < 4; ++j) { const int c = 4 * F.lane + 256 * j;
                const f32x4 g = *(const f32x4*)(gn + c), sc = *(const f32x4*)(md + sc_off + c), sh = *(const f32x4*)(md + sh_off + c);
                const f32x4 o = v[r][j] * rstd * g * (sc + 1.0f) + sh;
                u32x2v w; w.x = pg8::cvt_pk_bf16(o.x, o.y); w.y = pg8::cvt_pk_bf16(o.z, o.w); *(u32x2v*)(((bf16*)(F.ws + WS_XN)) + (size_t)m * DM + c) = w; } }
    }
}

__device__ __forceinline__ void p4_tile(Frame& F, int m0, int nrows, const bf16x8 (&Bf)[2][2][4], const float (&brg)[4], const float (&big)[4], const float (&spl)[4]) {
    const int lane = F.lane, w = F.wave;
    const bool samp = (m0 >= MP);
    {
        const int d0 = (8 * lane) & 63, l8 = lane & 7;
        float gq[8], gk[8];
        { const f32x4 a = *(const f32x4*)(F.inp(15) + d0), b = *(const f32x4*)(F.inp(15) + d0 + 4), c = *(const f32x4*)(F.inp(16) + d0), d = *(const f32x4*)(F.inp(16) + d0 + 4);
          gq[0] = a.x; gq[1] = a.y; gq[2] = a.z; gq[3] = a.w; gq[4] = b.x; gq[5] = b.y; gq[6] = b.z; gq[7] = b.w;
          gk[0] = c.x; gk[1] = c.y; gk[2] = c.z; gk[3] = c.w; gk[4] = d.x; gk[5] = d.y; gk[6] = d.z; gk[7] = d.w; }
        const int rpw = nrows >> 3;
#pragma unroll 2
        for (int rr = 0; rr < rpw; ++rr) {
            const int m = m0 + w * rpw + rr;
            const int tt = samp ? ((m - MP) & 3) : (m & (SEQ - 1));
            const int pos = samp ? PAST + tt : tt;
            const bf16* prow = ((bf16*)(F.ws + WS_PROJ)) + (size_t)m * NIN;
            const v4u qraw = *(const v4u*)(prow + 8 * lane), kraw = *(const v4u*)(prow + 512 + 8 * lane), vraw = *(const v4u*)(prow + 1024 + 8 * lane);
            float q[8], k[8], v[8]; unpack8(qraw, q); unpack8(kraw, k); unpack8(vraw, v);
            float sq = 0.f, sk = 0.f;
#pragma unroll
            for (int j = 0; j < 8; ++j) { sq += q[j] * q[j]; sk += k[j] * k[j]; }
            sq += __shfl_xor(sq, 1); sk += __shfl_xor(sk, 1); sq += __shfl_xor(sq, 2); sk += __shfl_xor(sk, 2); sq += __shfl_xor(sq, 4); sk += __shfl_xor(sk, 4);
            const float rq = rsqrtf(sq * (1.0f / 64.0f) + EPS), rk = rsqrtf(sk * (1.0f / 64.0f) + EPS);
#pragma unroll
            for (int j = 0; j < 8; ++j) { q[j] *= rq * gq[j]; k[j] *= rk * gk[j]; }
            const float* rp = ((float*)(F.ws + WS_ROPE)) + (size_t)pos * 16;
            const f32x4 t0 = *(const f32x4*)(rp), t1 = *(const f32x4*)(rp + 4), t2 = *(const f32x4*)(rp + 8), t3 = *(const f32x4*)(rp + 12);
            const float cs[8] = {t0.x, t0.z, t1.x, t1.z, t2.x, t2.z, t3.x, t3.z}, sn[8] = {t0.y, t0.w, t1.y, t1.w, t2.y, t2.w, t3.y, t3.w};
#pragma unroll
            for (int j = 0; j < 8; ++j) { const float pq = __shfl_xor(q[j], 1), pk = __shfl_xor(k[j], 1);
                if (l8 == 0) { q[j] = q[j] * cs[j] - pq * sn[j]; k[j] = k[j] * cs[j] - pk * sn[j]; }
                else if (l8 == 1) { q[j] = pq * sn[j] + q[j] * cs[j]; k[j] = pk * sn[j] + k[j] * cs[j]; } }
            float* kout = samp ? F.out + O_KS + (size_t)(m - MP) * 512 + 8 * lane : F.out + O_KP + (size_t)m * 512 + 8 * lane;
            float* vout = samp ? F.out + O_VS + (size_t)(m - MP) * 512 + 8 * lane : F.out + O_VP + (size_t)m * 512 + 8 * lane;
            *(f32x4*)kout = (f32x4){k[0], k[1], k[2], k[3]}; *(f32x4*)(kout + 4) = (f32x4){k[4], k[5], k[6], k[7]};
            *(f32x4*)vout = (f32x4){v[0], v[1], v[2], v[3]}; *(f32x4*)(vout + 4) = (f32x4){v[4], v[5], v[6], v[7]};
            *(v4u*)(((bf16*)(F.ws + WS_KB)) + (size_t)m * 512 + 8 * lane) = pack8(k);
#pragma unroll
            for (int j = 0; j < 8; ++j) q[j] *= C2;
            *(v4u*)(((bf16*)(F.ws + WS_QB)) + (size_t)m * 512 + 8 * lane) = pack8(q);
            const int kk = samp ? tt - 1 : tt - (SEQ - 3);
            if (kk >= 0) {
                const v4u lraw = *(const v4u*)(prow + 1536 + 8 * lane); float lx[8]; unpack8(lraw, lx);
                float* lo = samp ? F.out + O_LCS + ((size_t)((m - MP) >> 2) * 3 + kk) * 512 + 8 * lane : F.out + O_LCP + ((size_t)(m >> 12) * 3 + kk) * 512 + 8 * lane;
                *(f32x4*)lo = (f32x4){lx[0], lx[1], lx[2], lx[3]}; *(f32x4*)(lo + 4) = (f32x4){lx[4], lx[5], lx[6], lx[7]};
            }
        }
    }
    {
        LAS float* XC = (LAS float*)(F.lds + RING_OFF + w * 8704);
        LAS float* LA = XC + 16 * 68;
        const int ch0 = w * 64, c8 = lane & 7, tr = lane >> 3, fr = lane & 15, fq = lane >> 4;
        float cw[4][8], cb[8];
#pragma unroll
        for (int k = 0; k < 4; ++k) { const f32x4 a = *(const f32x4*)(F.inp(23) + k * 512 + ch0 + 8 * c8), b = *(const f32x4*)(F.inp(23) + k * 512 + ch0 + 8 * c8 + 4);
            cw[k][0] = a.x; cw[k][1] = a.y; cw[k][2] = a.z; cw[k][3] = a.w; cw[k][4] = b.x; cw[k][5] = b.y; cw[k][6] = b.z; cw[k][7] = b.w; }
        { const f32x4 a = *(const f32x4*)(F.inp(24) + ch0 + 8 * c8), b = *(const f32x4*)(F.inp(24) + ch0 + 8 * c8 + 4);
          cb[0] = a.x; cb[1] = a.y; cb[2] = a.z; cb[3] = a.w; cb[4] = b.x; cb[5] = b.y; cb[6] = b.z; cb[7] = b.w; }
        float hA = 1.0f, hB = 0.0f;
        const int nsub = nrows >> 4;
        for (int sub = 0; sub < nsub; ++sub) {
            const int mt = m0 + 16 * sub;
#pragma unroll
            for (int i = 0; i < 2; ++i) {
                const int tok = tr + 8 * i, m = mt + tok;
                const int tt = samp ? ((m - MP) & 3) : (m & (SEQ - 1));
                float acc[8];
#pragma unroll
                for (int j = 0; j < 8; ++j) acc[j] = cb[j];
#pragma unroll
                for (int kk = 0; kk < 4; ++kk) {
                    float lx[8];
                    if (tt - kk >= 0) { const v4u r = *(const v4u*)(((bf16*)(F.ws + WS_PROJ)) + (size_t)(m - kk) * NIN + 1536 + ch0 + 8 * c8); unpack8(r, lx); }
                    else if (samp) { const float* sp = F.inp(5) + ((size_t)((m - MP) >> 2) * 3 + (tt - kk + 3)) * 512 + ch0 + 8 * c8;
                        const f32x4 a = *(const f32x4*)sp, b = *(const f32x4*)(sp + 4); lx[0] = a.x; lx[1] = a.y; lx[2] = a.z; lx[3] = a.w; lx[4] = b.x; lx[5] = b.y; lx[6] = b.z; lx[7] = b.w; }
                    else {
#pragma unroll
                        for (int j = 0; j < 8; ++j) lx[j] = 0.f; }
#pragma unroll
                    for (int j = 0; j < 8; ++j) acc[j] += cw[3 - kk][j] * lx[j];
                }
                *(LAS f32x4*)(XC + tok * 68 + 8 * c8) = (f32x4){acc[0], acc[1], acc[2], acc[3]};
                *(LAS f32x4*)(XC + tok * 68 + 8 * c8 + 4) = (f32x4){acc[4], acc[5], acc[6], acc[7]};
            }
            LDS_WAIT(); asm volatile("" ::: "memory");
            f32x4 Dr[4], Di[4];
#pragma unroll
            for (int ct = 0; ct < 4; ++ct) { Dr[ct] = (f32x4){0.f, 0.f, 0.f, 0.f}; Di[ct] = (f32x4){0.f, 0.f, 0.f, 0.f}; }
#pragma unroll
            for (int s = 0; s < 2; ++s) {
                const LAS float* ap = XC + fr * 68 + 32 * s + 8 * fq;
                const f32x4 a0 = *(const LAS f32x4*)ap, a1 = *(const LAS f32x4*)(ap + 4);
                v4u aw; aw.x = pg8::cvt_pk_bf16(a0.x, a0.y); aw.y = pg8::cvt_pk_bf16(a0.z, a0.w); aw.z = pg8::cvt_pk_bf16(a1.x, a1.y); aw.w = pg8::cvt_pk_bf16(a1.z, a1.w);
                const bf16x8 af = __builtin_bit_cast(bf16x8, aw);
#pragma unroll
                for (int ct = 0; ct < 4; ++ct) { Dr[ct] = __builtin_amdgcn_mfma_f32_16x16x32_bf16(af, Bf[0][s][ct], Dr[ct], 0, 0, 0); Di[ct] = __builtin_amdgcn_mfma_f32_16x16x32_bf16(af, Bf[1][s][ct], Di[ct], 0, 0, 0); }
            }
#pragma unroll
            for (int ct = 0; ct < 4; ++ct)
#pragma unroll
                for (int i = 0; i < 4; ++i) { const int o = (4 * fq + i) * 68 + 16 * ct + fr;
                    const float xcv = XC[o], r = sigmoidf_(Dr[ct][i] + brg[ct]), ig = sigmoidf_(Di[ct][i] + big[ct]);
                    const float la = -8.0f * r * spl[ct], a = __expf(la), x2 = 2.0f * la;
                    const float em = (x2 > -0.1f) ? x2 * (1.0f + x2 * (0.5f + x2 * (0.16666667f + x2 * 0.041666668f))) : __expf(x2) - 1.0f;
                    LA[o] = a; XC[o] = sqrtf(-em) * ig * xcv; }
            LDS_WAIT(); asm volatile("" ::: "memory");
#pragma unroll
            for (int tok = 0; tok < 16; ++tok) {
                if (samp && (tok & 3) == 0) { hB = F.inp(6)[(size_t)((mt + tok - MP) >> 2) * 512 + ch0 + lane]; hA = 1.0f; }
                const float a = LA[tok * 68 + lane], bb = XC[tok * 68 + lane];
                hB = a * hB + bb; hA *= a; XC[tok * 68 + lane] = hB; LA[tok * 68 + lane] = hA;
            }
            LDS_WAIT(); asm volatile("" ::: "memory");
#pragma unroll
            for (int i = 0; i < 2; ++i) { const int tok = tr + 8 * i; const size_t go = (size_t)(mt + tok) * 512 + ch0 + 8 * c8;
                const f32x4 h0 = *(const LAS f32x4*)(XC + tok * 68 + 8 * c8), h1 = *(const LAS f32x4*)(XC + tok * 68 + 8 * c8 + 4);
                const f32x4 a0 = *(const LAS f32x4*)(LA + tok * 68 + 8 * c8), a1 = *(const LAS f32x4*)(LA + tok * 68 + 8 * c8 + 4);
                v4u hw, awv; hw.x = pg8::cvt_pk_bf16(h0.x, h0.y); hw.y = pg8::cvt_pk_bf16(h0.z, h0.w); hw.z = pg8::cvt_pk_bf16(h1.x, h1.y); hw.w = pg8::cvt_pk_bf16(h1.z, h1.w);
                awv.x = pg8::cvt_pk_bf16(a0.x, a0.y); awv.y = pg8::cvt_pk_bf16(a0.z, a0.w); awv.z = pg8::cvt_pk_bf16(a1.x, a1.y); awv.w = pg8::cvt_pk_bf16(a1.z, a1.w);
                *(v4u*)(((bf16*)(F.ws + WS_HL)) + go) = hw; *(v4u*)(((bf16*)(F.ws + WS_CA)) + go) = awv; }
            LDS_WAIT(); asm volatile("" ::: "memory");
        }
        if (!samp) { const size_t so = ((size_t)(m0 >> 12) * 64 + ((m0 & (SEQ - 1)) >> 6)) * 512 + ch0 + lane; ((float*)(F.ws + WS_SEGA))[so] = hA; ((float*)(F.ws + WS_SEGB))[so] = hB; }
    }
}
__device__ __forceinline__ void p4_phase(Frame& F) {
    const int lane = F.lane, w = F.wave, fr = lane & 15, fq = lane >> 4;
    bf16x8 Bf[2][2][4];
#pragma unroll
    for (int gt = 0; gt < 2; ++gt) { const float* W = (gt == 0 ? F.inp(25) : F.inp(27)) + (size_t)w * 4096;
#pragma unroll
        for (int s = 0; s < 2; ++s)
#pragma unroll
            for (int ct = 0; ct < 4; ++ct) { float e[8];
#pragma unroll
                for (int j = 0; j < 8; ++j) e[j] = W[(32 * s + 8 * fq + j) * 64 + 16 * ct + fr];
                Bf[gt][s][ct] = __builtin_bit_cast(bf16x8, pack8(e)); } }
    float brg[4], big[4], spl[4];
#pragma unroll
    for (int ct = 0; ct < 4; ++ct) { const int ch = w * 64 + 16 * ct + fr; brg[ct] = F.inp(26)[ch]; big[ct] = F.inp(28)[ch]; spl[ct] = log1pf(__expf(-F.inp(29)[ch])); }
    { int tp = F.vcu, tq = F.G - 1 - F.vcu;
      for (;;) { int m0, nrows; if (tp < 256) { m0 = 64 * tp; nrows = 64; tp += F.G; } else if (tq < 32) { m0 = MP + 16 * tq; nrows = 16; tq += F.G; } else break;
          p4_tile(F, m0, nrows, Bf, brg, big, spl); } }
}

template <int CTRL> __device__ __forceinline__ float dppf(float x) { return __builtin_bit_cast(float, __builtin_amdgcn_mov_dpp(__builtin_bit_cast(int, x), CTRL, 0xf, 0xf, true)); }
constexpr int DPP_XOR1 = 0xB1, DPP_XOR2 = 0x4E, DPP_XOR7 = 0x141, DPP_ROR8 = 0x128, DPP_ROR4 = 0x124;
__device__ __forceinline__ float sa_group(const f32x4& k0, const f32x4& k1, const f32x4& k2, const f32x4& k3, const f32x2v (&qp)[2][4], int l16) {
    float v[16];
#pragma unroll
    for (int pr = 0; pr < 2; ++pr) {
        f32x2v a0 = qp[pr][0] * k0.x, a1 = qp[pr][0] * k1.x, a2 = qp[pr][0] * k2.x, a3 = qp[pr][0] * k3.x;
        a0 = qp[pr][1] * k0.y + a0; a1 = qp[pr][1] * k1.y + a1; a2 = qp[pr][1] * k2.y + a2; a3 = qp[pr][1] * k3.y + a3;
        a0 = qp[pr][2] * k0.z + a0; a1 = qp[pr][2] * k1.z + a1; a2 = qp[pr][2] * k2.z + a2; a3 = qp[pr][2] * k3.z + a3;
        a0 = qp[pr][3] * k0.w + a0; a1 = qp[pr][3] * k1.w + a1; a2 = qp[pr][3] * k2.w + a2; a3 = qp[pr][3] * k3.w + a3;
        v[0 + 2 * pr] = a0.x; v[1 + 2 * pr] = a0.y; v[4 + 2 * pr] = a1.x; v[5 + 2 * pr] = a1.y; v[8 + 2 * pr] = a2.x; v[9 + 2 * pr] = a2.y; v[12 + 2 * pr] = a3.x; v[13 + 2 * pr] = a3.y;
    }
    const bool b3 = (l16 & 8) != 0, b2 = (l16 & 4) != 0, b1 = (l16 & 2) != 0, b0 = (l16 & 1) != 0;
#pragma unroll
    for (int a = 0; a < 8; ++a) { const float keep = b3 ? v[a + 8] : v[a], send = b3 ? v[a] : v[a + 8]; v[a] = keep + dppf<DPP_ROR8>(send); }
#pragma unroll
    for (int a = 0; a < 4; ++a) { const float keep = b2 ? v[a + 4] : v[a], send = b2 ? v[a] : v[a + 4]; v[a] = keep + dppf<DPP_XOR7>(send); }
#pragma unroll
    for (int a = 0; a < 2; ++a) { const float keep = b1 ? v[a + 2] : v[a], send = b1 ? v[a] : v[a + 2]; v[a] = keep + dppf<DPP_XOR2>(send); }
    const float keep = b0 ? v[1] : v[0], send = b0 ? v[0] : v[1];
    return keep + dppf<DPP_XOR1>(send);
}
__device__ __forceinline__ f32x4 ntload4(const float* p) { return __builtin_nontemporal_load((const f32x4*)p); }
__device__ __forceinline__ void sattn_unit(Frame& F, int s, int hp, float lam) {
    const int lane = F.lane, w = F.wave, l16 = lane & 15, grp = lane >> 4;
    LAS float* SB = (LAS float*)(F.lds + RING_OFF) + w * 4096;
    const int mrow0 = MP + s * 4;
    const int qcol = (2 * hp + (grp >> 1)) * 128 + (grp & 1) * 64 + 4 * l16;
    f32x2v qp[2][4];
    { float q[4][4];
#pragma unroll
      for (int qi = 0; qi < 4; ++qi) { const u32x2v r = *(const u32x2v*)(((bf16*)(F.ws + WS_QB)) + (size_t)(mrow0 + qi) * 512 + qcol); q[qi][0] = bflo(r.x); q[qi][1] = bfhi(r.x); q[qi][2] = bflo(r.y); q[qi][3] = bfhi(r.y); }
#pragma unroll
      for (int pr = 0; pr < 2; ++pr)
#pragma unroll
          for (int e = 0; e < 4; ++e) qp[pr][e] = (f32x2v){q[2 * pr][e], q[2 * pr + 1][e]}; }
    const int* ptab = ((const int*)(const GAS int*)F.kin[4]) + s * 16 + 2 * w;
    const int pg0 = __builtin_amdgcn_readfirstlane(ptab[0]), pg1 = __builtin_amdgcn_readfirstlane(ptab[1]);
    const int ridx = (l16 >> 2) * 16 + grp * 4 + (l16 & 3);
    float mx = -INFINITY;
    {
        const __amdgpu_buffer_rsrc_t rk = __builtin_amdgcn_make_buffer_rsrc((void*)F.inp(2), 0, 2560 * 128 * 512 * 4, 0x00020000);
        const unsigned kb0 = (unsigned)pg0 * 262144u + (unsigned)hp * 1024u, kb1 = (unsigned)pg1 * 262144u + (unsigned)hp * 1024u;
        const unsigned lane16 = 16u * (unsigned)lane;
        f32x4 kb[6][4];
#define SA_LOADK(B, G) do { const int g_ = (G) < 64 ? (G) : 63, j0_ = 4 * g_; const unsigned so_ = ((j0_ < 128) ? kb0 : kb1) + (unsigned)(j0_ & 127) * 2048u; \
            _Pragma("unroll") for (int i_ = 0; i_ < 4; ++i_) kb[B][i_] = __builtin_bit_cast(f32x4, __builtin_amdgcn_raw_buffer_load_b128(rk, lane16, so_ + (unsigned)i_ * 2048u, 2)); } while (0)
#define SA_STEPK(B, G) do { const float s0_ = sa_group(kb[B][0], kb[B][1], kb[B][2], kb[B][3], qp, l16); \
            SB[(G) * 64 + ridx] = s0_; mx = fmaxf(mx, s0_); __builtin_amdgcn_sched_barrier(0); } while (0)
        SA_LOADK(0, 0); SA_LOADK(1, 1); SA_LOADK(2, 2); SA_LOADK(3, 3); SA_LOADK(4, 4);
#pragma nounroll
        for (int g = 0; g < 60; g += 6) {
            SA_LOADK(5, g + 5);  SA_STEPK(0, g);
            SA_LOADK(0, g + 6);  SA_STEPK(1, g + 1);
            SA_LOADK(1, g + 7);  SA_STEPK(2, g + 2);
            SA_LOADK(2, g + 8);  SA_STEPK(3, g + 3);
            SA_LOADK(3, g + 9);  SA_STEPK(4, g + 4);
            SA_LOADK(4, g + 10); SA_STEPK(5, g + 5);
        }
        SA_STEPK(0, 60); SA_STEPK(1, 61); SA_STEPK(2, 62); SA_STEPK(3, 63);
#undef SA_LOADK
#undef SA_STEPK
    }
    int NG = 64;
    if (w == 7) {
        f32x4 kn[4];
#pragma unroll
        for (int g = 0; g < 4; ++g) { const u32x2v r = *(const u32x2v*)(((bf16*)(F.ws + WS_KB)) + (size_t)(mrow0 + g) * 512 + qcol); kn[g] = (f32x4){bflo(r.x), bfhi(r.x), bflo(r.y), bfhi(r.y)}; }
        float sc = sa_group(kn[0], kn[1], kn[2], kn[3], qp, l16);
        if ((l16 >> 2) > (l16 & 3)) sc = -INFINITY;
        SB[64 * 64 + ridx] = sc; mx = fmaxf(mx, sc); NG = 65;
    }
    mx = fmaxf(mx, dppf<DPP_ROR4>(mx)); mx = fmaxf(mx, dppf<DPP_ROR8>(mx));
    LDS_WAIT(); asm volatile("" ::: "memory");
    float ls = 0.f;
    for (int g = 0; g < NG; ++g) { const float p = __builtin_amdgcn_exp2f(SB[g * 64 + ridx] - mx); ls += p; SB[g * 64 + ridx] = p; }
    ls += dppf<DPP_ROR4>(ls); ls += dppf<DPP_ROR8>(ls);
    LDS_WAIT(); asm volatile("" ::: "memory");
    const int hh = lane >> 5, dv4 = 4 * (lane & 31);
    f32x4 O[8];
#pragma unroll
    for (int r = 0; r < 8; ++r) O[r] = (f32x4){0.f, 0.f, 0.f, 0.f};
    {
        const __amdgpu_buffer_rsrc_t rv = __builtin_amdgcn_make_buffer_rsrc((void*)F.inp(3), 0, 2560 * 128 * 512 * 4, 0x00020000);
        const unsigned vb0 = (unsigned)pg0 * 262144u + (unsigned)hp * 1024u, vb1 = (unsigned)pg1 * 262144u + (unsigned)hp * 1024u;
        const unsigned lane16 = 16u * (unsigned)lane;
        f32x4 vb[6][4];
#define SA_LOADV(B, G) do { const int g_ = (G) < 64 ? (G) : 63, j0_ = 4 * g_; const unsigned so_ = ((j0_ < 128) ? vb0 : vb1) + (unsigned)(j0_ & 127) * 2048u; \
            _Pragma("unroll") for (int i_ = 0; i_ < 4; ++i_) vb[B][i_] = __builtin_bit_cast(f32x4, __builtin_amdgcn_raw_buffer_load_b128(rv, lane16, so_ + (unsigned)i_ * 2048u, 2)); } while (0)
#define SA_STEPV(B, G) do { _Pragma("unroll") for (int i_ = 0; i_ < 4; ++i_) { const LAS f32x4* pp_ = (const LAS f32x4*)(SB + (4 * (G) + i_) * 16 + hh * 8); const f32x4 p0_ = pp_[0], p1_ = pp_[1]; \
            _Pragma("unroll") for (int r_ = 0; r_ < 4; ++r_) { O[r_] += vb[B][i_] * p0_[r_]; O[4 + r_] += vb[B][i_] * p1_[r_]; } } __builtin_amdgcn_sched_barrier(0); } while (0)
        SA_LOADV(0, 0); SA_LOADV(1, 1); SA_LOADV(2, 2); SA_LOADV(3, 3); SA_LOADV(4, 4);
#pragma nounroll
        for (int g = 0; g < 60; g += 6) {
            SA_LOADV(5, g + 5);  SA_STEPV(0, g);
            SA_LOADV(0, g + 6);  SA_STEPV(1, g + 1);
            SA_LOADV(1, g + 7);  SA_STEPV(2, g + 2);
            SA_LOADV(2, g + 8);  SA_STEPV(3, g + 3);
            SA_LOADV(3, g + 9);  SA_STEPV(4, g + 4);
            SA_LOADV(4, g + 10); SA_STEPV(5, g + 5);
        }
        SA_STEPV(0, 60); SA_STEPV(1, 61); SA_STEPV(2, 62); SA_STEPV(3, 63);
#undef SA_LOADV
#undef SA_STEPV
        if (w == 7) {
#pragma unroll
            for (int g = 0; g < 4; ++g) { const u32x2v r = *(const u32x2v*)(((bf16*)(F.ws + WS_PROJ)) + (size_t)(mrow0 + g) * NIN + 1024 + (2 * hp + hh) * 128 + dv4);
                const f32x4 vv = (f32x4){bflo(r.x), bfhi(r.x), bflo(r.y), bfhi(r.y)};
                const LAS f32x4* pp = (const LAS f32x4*)(SB + (256 + g) * 16 + hh * 8); const f32x4 p0 = pp[0], p1 = pp[1];
#pragma unroll
                for (int rr = 0; rr < 4; ++rr) { O[rr] += vv * p0[rr]; O[4 + rr] += vv * p1[rr]; } }
        }
    }
    LDS_WAIT(); __syncthreads();
    LAS float* OW = (LAS float*)(F.lds + RING_OFF);
    LAS float* ML = OW + 8 * 16 * 128;
#pragma unroll
    for (int r = 0; r < 8; ++r) *(LAS f32x4*)(OW + (size_t)((w * 16 + hh * 8 + r) * 128) + dv4) = O[r];
    if (l16 < 4) { const int row16 = grp * 4 + l16; ML[(w * 16 + row16) * 2] = mx; ML[(w * 16 + row16) * 2 + 1] = ls; }
    LDS_WAIT(); __syncthreads();
    {
        const int hh2 = w >> 2, qi = w & 3; float oc[2][2];
#pragma unroll
        for (int c = 0; c < 2; ++c) { const int row16 = hh2 * 8 + c * 4 + qi; float M = -INFINITY;
#pragma unroll
            for (int ww = 0; ww < 8; ++ww) M = fmaxf(M, ML[(ww * 16 + row16) * 2]);
            float L = 0.f, a0 = 0.f, a1 = 0.f;
#pragma unroll
            for (int ww = 0; ww < 8; ++ww) { const float f = __builtin_amdgcn_exp2f(ML[(ww * 16 + row16) * 2] - M); L += f * ML[(ww * 16 + row16) * 2 + 1];
                const f32x2v o = *(const LAS f32x2v*)(OW + (ww * 16 + row16) * 128 + 2 * lane); a0 += f * o.x; a1 += f * o.y; }
            const float inv = 1.0f / L; oc[c][0] = a0 * inv; oc[c][1] = a1 * inv; }
        const float o0 = oc[0][0] - lam * oc[1][0], o1 = oc[0][1] - lam * oc[1][1];
        const float rstd = rsqrtf(wave_sum(o0 * o0 + o1 * o1) * (1.0f / 128.0f) + EPS);
        const float g0 = F.inp(21)[2 * lane], g1 = F.inp(21)[2 * lane + 1];
        *(unsigned*)(((bf16*)(F.ws + WS_MIX)) + (size_t)(mrow0 + qi) * DM + (2 * hp + hh2) * 128 + 2 * lane) = pg8::cvt_pk_bf16(o0 * rstd * g0 * (1.0f - LAM0), o1 * rstd * g1 * (1.0f - LAM0));
    }
    LDS_WAIT(); __syncthreads();
}
__device__ __forceinline__ float diff_lambda(Frame& F) {
    const float a = wave_sum(F.inp(17)[F.lane] * F.inp(18)[F.lane]), b = wave_sum(F.inp(19)[F.lane] * F.inp(20)[F.lane]);
    return __expf(a) - __expf(b) + LAM0;
}


__device__ __forceinline__ int q_pop(Frame& F, int kind, int q, int bank) {
    volatile LAS int* slot = (volatile LAS int*)(F.lds + LDSCTL_OFF);
    if (threadIdx.x == 0) *slot = (int)__hip_atomic_fetch_add((unsigned*)(F.ctl + CW_Q + bank * 1024 + (kind * 8 + q) * 64), 1u, __ATOMIC_RELAXED, __HIP_MEMORY_SCOPE_AGENT);
    __syncthreads();
    const int r = *slot;
    __syncthreads();
    return r;
}

__device__ __forceinline__ void p6_tile(Frame& F, int m0, int nrows, float lam) {
    const int lane = F.lane, w = F.wave;
    const bool samp = (m0 >= MP);
    LAS float* CARRY = (LAS float*)(F.lds + RING_OFF);
    {
        float carry = 0.f;
        if (!samp) { const int b = m0 >> 12, seg = (m0 & (SEQ - 1)) >> 6; const float* pa = ((float*)(F.ws + WS_SEGA)) + (size_t)b * 64 * 512 + F.tid; const float* pb = ((float*)(F.ws + WS_SEGB)) + (size_t)b * 64 * 512 + F.tid;
#pragma unroll 8
            for (int sg = 0; sg < seg; ++sg) carry = pa[(size_t)sg * 512] * carry + pb[(size_t)sg * 512]; }
        CARRY[F.tid] = carry;
    }
    LDS_WAIT(); __syncthreads();
    float cr[8];
    { const f32x4 a = *(const LAS f32x4*)(CARRY + 8 * lane), b = *(const LAS f32x4*)(CARRY + 8 * lane + 4); cr[0] = a.x; cr[1] = a.y; cr[2] = a.z; cr[3] = a.w; cr[4] = b.x; cr[5] = b.y; cr[6] = b.z; cr[7] = b.w; }
    float gs[8];
    { const int dv = 8 * (lane & 15); const f32x4 a = *(const f32x4*)(F.inp(21) + dv), b = *(const f32x4*)(F.inp(21) + dv + 4); gs[0] = a.x; gs[1] = a.y; gs[2] = a.z; gs[3] = a.w; gs[4] = b.x; gs[5] = b.y; gs[6] = b.z; gs[7] = b.w; }
    const int rpw = nrows >> 3;
#pragma unroll 2
    for (int rr = 0; rr < rpw; ++rr) {
        const int m = m0 + w * rpw + rr;
        if (!samp) {
            const bf16* orow = ((bf16*)(F.ws + WS_OB)) + (size_t)m * 1024 + (lane >> 4) * 256 + 8 * (lane & 15);
            const v4u r0 = *(const v4u*)orow, r1 = *(const v4u*)(orow + 128);
            float o0[8], o1[8]; unpack8(r0, o0); unpack8(r1, o1);
            float ss = 0.f;
#pragma unroll
            for (int j = 0; j < 8; ++j) { o0[j] -= lam * o1[j]; ss += o0[j] * o0[j]; }
            ss += __shfl_xor(ss, 1); ss += __shfl_xor(ss, 2); ss += __shfl_xor(ss, 4); ss += __shfl_xor(ss, 8);
            const float rstd = rsqrtf(ss * (1.0f / 128.0f) + EPS) * (1.0f - LAM0);
#pragma unroll
            for (int j = 0; j < 8; ++j) o0[j] *= rstd * gs[j];
            *(v4u*)(((bf16*)(F.ws + WS_MIX)) + (size_t)m * DM + 8 * lane) = pack8(o0);
        }
        {
            const v4u hr = *(const v4u*)(((bf16*)(F.ws + WS_HL)) + (size_t)m * 512 + 8 * lane), ar = *(const v4u*)(((bf16*)(F.ws + WS_CA)) + (size_t)m * 512 + 8 * lane), gr = *(const v4u*)(((bf16*)(F.ws + WS_PROJ)) + (size_t)m * NIN + 2048 + 8 * lane);
            float h[8], a[8], lg[8]; unpack8(hr, h); unpack8(ar, a); unpack8(gr, lg);
#pragma unroll
            for (int j = 0; j < 8; ++j) h[j] += a[j] * cr[j];
            const int tt = samp ? ((m - MP) & 3) : (m & (SEQ - 1));
            if (tt == (samp ? 3 : SEQ - 1)) { float* ho = samp ? F.out + O_LHS + (size_t)((m - MP) >> 2) * 512 + 8 * lane : F.out + O_LHP + (size_t)(m >> 12) * 512 + 8 * lane;
                *(f32x4*)ho = (f32x4){h[0], h[1], h[2], h[3]}; *(f32x4*)(ho + 4) = (f32x4){h[4], h[5], h[6], h[7]}; }
#pragma unroll
            for (int j = 0; j < 8; ++j) h[j] *= gelu_tanh(lg[j]);
            *(v4u*)(((bf16*)(F.ws + WS_MIX)) + (size_t)m * DM + 512 + 8 * lane) = pack8(h);
        }
    }
    LDS_WAIT(); __syncthreads();
}


template <int K> __device__ __forceinline__ void sample_gemm(Frame& F, const bf16* A, const bf16* Bt, const float* bs, const float* gate, float* out) {
    constexpr int KW = K / 8, NS = KW / 32;
    static_assert(KW % 32 == 0, "K/8 must be a multiple of 32");
    const int lane = F.lane, w = F.wave, fr = lane & 15, fq = lane >> 4;
    for (int blk = F.vcu; blk < 256; blk += F.G) {
        const int rb = blk >> 4, cb = blk & 15;
        const bf16* ap = A + (size_t)(MP + 32 * rb + fr) * K + w * KW + 8 * fq;
        const bf16* bp = Bt + (size_t)(64 * cb + fr) * K + w * KW + 8 * fq;
        f32x4 D[2][4];
#pragma unroll
        for (int rt = 0; rt < 2; ++rt)
#pragma unroll
            for (int ct = 0; ct < 4; ++ct) D[rt][ct] = (f32x4){0.f, 0.f, 0.f, 0.f};
#pragma unroll
        for (int s = 0; s < NS; ++s) {
            bf16x8 af[2], bfr[4];
#pragma unroll
            for (int rt = 0; rt < 2; ++rt) af[rt] = *(const bf16x8*)(ap + (size_t)(16 * rt) * K + 32 * s);
#pragma unroll
            for (int ct = 0; ct < 4; ++ct) bfr[ct] = *(const bf16x8*)(bp + (size_t)(16 * ct) * K + 32 * s);
#pragma unroll
            for (int rt = 0; rt < 2; ++rt)
#pragma unroll
                for (int ct = 0; ct < 4; ++ct) D[rt][ct] = __builtin_amdgcn_mfma_f32_16x16x32_bf16(af[rt], bfr[ct], D[rt][ct], 0, 0, 0);
        }
        LAS float* P = (LAS float*)(F.lds + RING_OFF) + w * 2048;
#pragma unroll
        for (int rt = 0; rt < 2; ++rt)
#pragma unroll
            for (int ct = 0; ct < 4; ++ct)
#pragma unroll
                for (int i = 0; i < 4; ++i) P[(16 * rt + 4 * fq + i) * 64 + 16 * ct + fr] = D[rt][ct][i];
        LDS_WAIT(); __syncthreads();
        { const int row = F.tid >> 4, c4 = (F.tid & 15) * 4; f32x4 acc = (f32x4){0.f, 0.f, 0.f, 0.f};
#pragma unroll
          for (int ww = 0; ww < 8; ++ww) acc += *(const LAS f32x4*)((LAS float*)(F.lds + RING_OFF) + ww * 2048 + row * 64 + c4);
          const int r = 32 * rb + row, col = 64 * cb + c4;
          const f32x4 bb = *(const f32x4*)(bs + (size_t)r * DM + col), gg = *(const f32x4*)(gate + (size_t)(4 + (r >> 2)) * NADA + col);
          *(f32x4*)(out + (size_t)(MP + r) * DM + col) = bb + gg * acc; }
        LDS_WAIT(); __syncthreads();
    }
}

__device__ __forceinline__ void p10_phase(Frame& F) {
    const int c = F.tid;
    const bool act = (c < DFF / 8);
    const int cg = act ? 8 * c : 0, cv = DFF + cg;
    float wg[3][8], wv[3][8], bg[8], bv[8];
#pragma unroll
    for (int k = 0; k < 3; ++k) { const f32x4 a = *(const f32x4*)(F.inp(31) + k * NUP + cg), b = *(const f32x4*)(F.inp(31) + k * NUP + cg + 4), d = *(const f32x4*)(F.inp(31) + k * NUP + cv), e = *(const f32x4*)(F.inp(31) + k * NUP + cv + 4);
        wg[k][0] = a.x; wg[k][1] = a.y; wg[k][2] = a.z; wg[k][3] = a.w; wg[k][4] = b.x; wg[k][5] = b.y; wg[k][6] = b.z; wg[k][7] = b.w;
        wv[k][0] = d.x; wv[k][1] = d.y; wv[k][2] = d.z; wv[k][3] = d.w; wv[k][4] = e.x; wv[k][5] = e.y; wv[k][6] = e.z; wv[k][7] = e.w; }
    { const f32x4 a = *(const f32x4*)(F.inp(32) + cg), b = *(const f32x4*)(F.inp(32) + cg + 4), d = *(const f32x4*)(F.inp(32) + cv), e = *(const f32x4*)(F.inp(32) + cv + 4);
      bg[0] = a.x; bg[1] = a.y; bg[2] = a.z; bg[3] = a.w; bg[4] = b.x; bg[5] = b.y; bg[6] = b.z; bg[7] = b.w;
      bv[0] = d.x; bv[1] = d.y; bv[2] = d.z; bv[3] = d.w; bv[4] = e.x; bv[5] = e.y; bv[6] = e.z; bv[7] = e.w; }
    if (!act) return;
    for (int et = F.vcu; et < 128; et += F.G) {
        const int pm = et >> 1, r = et & 1; const bool first = ((pm & 15) == 0);
        const bf16* E0 = ((bf16*)(F.ws + WS_EDGE)) + (size_t)pm * 4 * NUP; const bf16* Ep = E0 - (size_t)4 * NUP;
        float g0[8], v0[8], g1[8], v1[8], g2[8], v2[8];
        unpack8(*(const v4u*)(E0 + (size_t)r * NUP + cg), g0); unpack8(*(const v4u*)(E0 + (size_t)r * NUP + cv), v0);
        const bf16* s1 = (r == 1) ? E0 : Ep + (size_t)3 * NUP; const bf16* s2 = (r == 1) ? Ep + (size_t)3 * NUP : Ep + (size_t)2 * NUP;
        const bool z1 = (r == 0) && first, z2 = first;
        if (z1) {
#pragma unroll
            for (int j = 0; j < 8; ++j) { g1[j] = 0.f; v1[j] = 0.f; } }
        else { unpack8(*(const v4u*)(s1 + cg), g1); unpack8(*(const v4u*)(s1 + cv), v1); }
        if (z2) {
#pragma unroll
            for (int j = 0; j < 8; ++j) { g2[j] = 0.f; v2[j] = 0.f; } }
        else { unpack8(*(const v4u*)(s2 + cg), g2); unpack8(*(const v4u*)(s2 + cv), v2); }
        float o[8];
#pragma unroll
        for (int j = 0; j < 8; ++j) { const float hg = bg[j] + wg[0][j] * g2[j] + wg[1][j] * g1[j] + wg[2][j] * g0[j], hv = bv[j] + wv[0][j] * v2[j] + wv[1][j] * v1[j] + wv[2][j] * v0[j];
            o[j] = hg / (1.0f + __expf(-hg)) * hv; }
        *(v4u*)(((bf16*)(F.ws + WS_ACT)) + (size_t)(256 * pm + r) * DFF + cg) = pack8(o);
    }
    for (int tile = MP / 16 + F.vcu; tile < MA / 16; tile += F.G) {
        const int m0 = tile * 16; const bool samp = true;
        const bf16* upg = ((bf16*)(F.ws + WS_UP)) + (size_t)m0 * NUP + cg; const bf16* upv = ((bf16*)(F.ws + WS_UP)) + (size_t)m0 * NUP + cv;
        v4u rg[2][4], rv[2][4];
#pragma unroll
        for (int i = 0; i < 4; ++i) { rg[0][i] = *(const v4u*)(upg + (size_t)i * NUP); rv[0][i] = *(const v4u*)(upv + (size_t)i * NUP); }
        float g2[8], v2[8], g1[8], v1[8];
        if (!samp) {
            if ((m0 & (SEQ - 1)) == 0) {
#pragma unroll
                for (int j = 0; j < 8; ++j) { g2[j] = 0.f; v2[j] = 0.f; g1[j] = 0.f; v1[j] = 0.f; } }
            else { unpack8(*(const v4u*)(upg - 2 * (size_t)NUP), g2); unpack8(*(const v4u*)(upv - 2 * (size_t)NUP), v2);
                   unpack8(*(const v4u*)(upg - (size_t)NUP), g1); unpack8(*(const v4u*)(upv - (size_t)NUP), v1); }
        }
#pragma unroll
        for (int bt = 0; bt < 4; ++bt) {
            const int cb = bt & 1, nb = cb ^ 1;
            if (bt < 3) {
#pragma unroll
                for (int i = 0; i < 4; ++i) { rg[nb][i] = *(const v4u*)(upg + (size_t)(4 * bt + 4 + i) * NUP); rv[nb][i] = *(const v4u*)(upv + (size_t)(4 * bt + 4 + i) * NUP); } }
            if (samp) {
                const float* sp = F.inp(7) + (size_t)((m0 + 4 * bt - MP) >> 2) * 2 * NUP;
                const f32x4 a = *(const f32x4*)(sp + cg), b = *(const f32x4*)(sp + cg + 4), d = *(const f32x4*)(sp + cv), e = *(const f32x4*)(sp + cv + 4);
                const f32x4 a1 = *(const f32x4*)(sp + NUP + cg), b1 = *(const f32x4*)(sp + NUP + cg + 4), d1 = *(const f32x4*)(sp + NUP + cv), e1 = *(const f32x4*)(sp + NUP + cv + 4);
                g2[0] = a.x; g2[1] = a.y; g2[2] = a.z; g2[3] = a.w; g2[4] = b.x; g2[5] = b.y; g2[6] = b.z; g2[7] = b.w;
                v2[0] = d.x; v2[1] = d.y; v2[2] = d.z; v2[3] = d.w; v2[4] = e.x; v2[5] = e.y; v2[6] = e.z; v2[7] = e.w;
                g1[0] = a1.x; g1[1] = a1.y; g1[2] = a1.z; g1[3] = a1.w; g1[4] = b1.x; g1[5] = b1.y; g1[6] = b1.z; g1[7] = b1.w;
                v1[0] = d1.x; v1[1] = d1.y; v1[2] = d1.z; v1[3] = d1.w; v1[4] = e1.x; v1[5] = e1.y; v1[6] = e1.z; v1[7] = e1.w; }
#pragma unroll
            for (int i = 0; i < 4; ++i) {
                const int m = m0 + 4 * bt + i;
                float g0[8], v0[8]; unpack8(rg[cb][i], g0); unpack8(rv[cb][i], v0);
                float o[8];
#pragma unroll
                for (int j = 0; j < 8; ++j) { const float hg = bg[j] + wg[0][j] * g2[j] + wg[1][j] * g1[j] + wg[2][j] * g0[j], hv = bv[j] + wv[0][j] * v2[j] + wv[1][j] * v1[j] + wv[2][j] * v0[j];
                    o[j] = hg / (1.0f + __expf(-hg)) * hv; }
                *(v4u*)(((bf16*)(F.ws + WS_ACT)) + (size_t)m * DFF + cg) = pack8(o);
                const int tt = samp ? ((m - MP) & 3) : (m & (SEQ - 1)); const int kk = samp ? tt - 2 : tt - (SEQ - 2);
                if (kk >= 0) { float* fo = samp ? F.out + O_FCS + ((size_t)((m - MP) >> 2) * 2 + kk) * NUP : F.out + O_FCP + ((size_t)(m >> 12) * 2 + kk) * NUP;
                    *(f32x4*)(fo + cg) = (f32x4){g0[0], g0[1], g0[2], g0[3]}; *(f32x4*)(fo + cg + 4) = (f32x4){g0[4], g0[5], g0[6], g0[7]};
                    *(f32x4*)(fo + cv) = (f32x4){v0[0], v0[1], v0[2], v0[3]}; *(f32x4*)(fo + cv + 4) = (f32x4){v0[4], v0[5], v0[6], v0[7]}; }
#pragma unroll
                for (int j = 0; j < 8; ++j) { g2[j] = g1[j]; v2[j] = v1[j]; g1[j] = g0[j]; v1[j] = v0[j]; }
            }
        }
    }
}

struct Args { const void* in[34]; float* out; unsigned char* ws; int ph_lo, ph_hi; };
constexpr int N_PHASES = 12;
__global__ void __launch_bounds__(NWAVES * 64, 2) mk_fwd(Args args) {
    extern __shared__ __attribute__((aligned(16))) unsigned char lds[];
    Frame F;
    F.lds = (LAS unsigned char*)lds;
    F.MISC = (volatile LAS unsigned*)(F.lds + MISC_OFF);
    F.tid = threadIdx.x; F.lane = F.tid & 63; F.wave = __builtin_amdgcn_readfirstlane(F.tid >> 6);
    F.G = gridDim.x; { const int bx = blockIdx.x; F.vcu = (F.G % 8 == 0) ? (bx % 8) * (F.G / 8) + bx / 8 : bx; }
    unsigned char* ws = (unsigned char*)(GAS unsigned char*)args.ws;
    F.ctl = (gu32*)(ws + WS_CTL);
    F.kin = (KIN)__builtin_amdgcn_kernarg_segment_ptr(); F.ws = ws; F.out = (float*)(GAS float*)args.out;
    for (int u = F.tid; u < (LDS_BYTES - LDSCTL_OFF) / 4; u += NWAVES * 64) ((LAS unsigned*)(F.lds + LDSCTL_OFF))[u] = 0u;
    __syncthreads();
    const int lo = args.ph_lo, hi = args.ph_hi;
    const bool one_launch = (hi - lo) > 1;
    XcdBarrier bar; bar.bar = (unsigned*)(F.ctl + CW_BAR); bar.x = 0; bar.st = nullptr;
    if (one_launch) bar = xcd_barrier_post((unsigned*)(F.ctl + CW_BAR), F.MISC + 8);
#define IN(k) (lo <= (k) && (k) < hi)
#define PHASE_IDS() do { int t_ = threadIdx.x; asm volatile("" : "+v"(t_)); F.tid = t_; F.lane = t_ & 63; } while (0)
#ifndef MK_REPEAT
#define MK_REPEAT 0
#endif
#define REP(k) for (int rep_ = 0; rep_ < (((MK_REPEAT >> (k)) & 1) + 1); ++rep_)
#define REPBAR() do { if (rep_ > 0) xcd_barrier(bar); } while (0)
#define SEAM(k) do { if (IN(k) && IN((k) + 1)) xcd_barrier(bar); } while (0)

    if (IN(0)) REP(0) { REPBAR(); PHASE_IDS(); p0_prologue(F); } SEAM(0);
    if (IN(1)) REP(1) { REPBAR(); PHASE_IDS(); pg8::Gemm g{((bf16*)(F.ws + WS_SC)), ((bf16*)(F.ws + WS_WADA)), 256, NADA, DM}; pg8::StaticOrder S; S.init(256, NADA, F.G, (int)blockIdx.x);
        pg8::EpiF32Bias E{((float*)(F.ws + WS_MOD)), NADA, F.inp(13)};
        pg8::gemm_phase<pg8::EpiF32Bias, pg8::StaticOrder, PG8_ALIGN, PG8_SP2>(F.lds + RING_OFF, g, S, E); } SEAM(1);
    if (IN(2)) REP(2) { REPBAR(); PHASE_IDS(); norm_mod_rows(F, F.inp(0), F.inp(1), F.inp(10), 1024, 0); } SEAM(2);
    if (IN(3)) REP(3) { REPBAR(); PHASE_IDS(); pg8::Gemm g{((bf16*)(F.ws + WS_XN)), ((bf16*)(F.ws + WS_WIN)), MA, NIN, DM}; pg8::StaticOrder S; S.init(MA, NIN, F.G, (int)blockIdx.x);
        pg8::EpiBf16<0> E{((bf16*)(F.ws + WS_PROJ)), NIN, nullptr, 0, 0, 1.f};
        pg8::gemm_phase<pg8::EpiBf16<0>, pg8::StaticOrder, PG8_ALIGN, PG8_SP2>(F.lds + RING_OFF, g, S, E); } SEAM(3);
    if (IN(4)) REP(4) { REPBAR(); PHASE_IDS(); p4_phase(F); } SEAM(4);
    if (IN(5)) REP(5) { REPBAR(); PHASE_IDS();
        const int home = (int)(xb_xcc_id() & 7u);
        const bool sfirst = ((blockIdx.x >> 3) & 3) == 3;
        const float lam = diff_lambda(F);
        for (int pass = 0; pass < 2; ++pass) {
            const int kind = ((pass == 0) == sfirst) ? 1 : 0;
#if defined(MK_P5_REP_ONLY)
            if (rep_ > 0 && kind != MK_P5_REP_ONLY) continue;
#if defined(MK_P5_REP_SFIRST)
            if (rep_ > 0 && !sfirst) continue;
#endif
#endif
            for (int dq = 0; dq < 8; ++dq) { const int q = (home + dq) & 7;
                for (;;) { const int idx = q_pop(F, kind, q, rep_); if (idx >= (kind ? 32 : 128)) break;
                    if (kind == 0) {
                        const int qb = 15 - (idx >> 3), bvh = 8 * q + (idx & 7), b = bvh >> 4, vh = bvh & 15, h = vh >> 2, c = (vh >> 1) & 1, half = vh & 1;
                        attn_body::attn_unit<8>(b, qb, (const attn_body::bf16*)((bf16*)(F.ws + WS_QB)) + h * 128 + c * 64, (const attn_body::bf16*)((bf16*)(F.ws + WS_KB)) + h * 128 + c * 64,
                                                (const attn_body::bf16*)((bf16*)(F.ws + WS_PROJ)) + 1024 + h * 128 + half * 64, (attn_body::bf16*)((bf16*)(F.ws + WS_OB)) + vh * 64, (char*)lds + RING_OFF);
                    } else { PHASE_IDS(); const int u = 32 * q + idx; sattn_unit(F, u >> 1, u & 1, lam); }
                } }
        }
    } SEAM(5);
    if (IN(6)) REP(6) { REPBAR(); PHASE_IDS(); const float lam = diff_lambda(F); int tp = F.vcu, tq = F.G - 1 - F.vcu;
        for (;;) { int m0, nrows; if (tp < 256) { m0 = 64 * tp; nrows = 64; tp += F.G; } else if (tq < 32) { m0 = MP + 16 * tq; nrows = 16; tq += F.G; } else break; p6_tile(F, m0, nrows, lam); } } SEAM(6);
    if (IN(7)) REP(7) { REPBAR(); PHASE_IDS(); sample_gemm<DM>(F, ((bf16*)(F.ws + WS_MIX)), ((bf16*)(F.ws + WS_WOUT)), F.inp(1), ((float*)(F.ws + WS_MOD)) + 2048, ((float*)(F.ws + WS_X1)));
        pg8::Gemm g{((bf16*)(F.ws + WS_MIX)), ((bf16*)(F.ws + WS_WOUT)), MP, DM, DM}; pg8::StaticOrder S; S.init(MP, DM, F.G, (int)blockIdx.x);
        pg8::EpiResGate E{F.inp(0), F.inp(1), ((float*)(F.ws + WS_MOD)) + 2048, ((float*)(F.ws + WS_X1))};
        pg8::gemm_phase<pg8::EpiResGate, pg8::StaticOrder, PG8_ALIGN, PG8_SP2>(F.lds + RING_OFF, g, S, E); } SEAM(7);
    if (IN(8)) REP(8) { REPBAR(); PHASE_IDS(); norm_mod_rows(F, ((float*)(F.ws + WS_X1)), ((float*)(F.ws + WS_X1)) + (size_t)MP * DM, F.inp(11), 4096, 3072); } SEAM(8);
    if (IN(9)) REP(9) { REPBAR(); PHASE_IDS(); pg8::Gemm g{((bf16*)(F.ws + WS_XN)), ((bf16*)(F.ws + WS_WUP)), MA, NUP, DM}; pg8::StaticOrder S; S.init(MA, NUP, F.G, (int)blockIdx.x);
        pg8::EpiConvGate E{((bf16*)(F.ws + WS_ACT)), ((bf16*)(F.ws + WS_UP)), ((bf16*)(F.ws + WS_EDGE)), F.inp(31), F.inp(32), F.out + O_FCP, (LAS float*)(F.lds + HTAB_OFF)};
        pg8::gemm_phase<pg8::EpiConvGate, pg8::StaticOrder, PG8_ALIGN, PG8_SP2>(F.lds + RING_OFF, g, S, E); } SEAM(9);
    if (IN(10)) REP(10) { REPBAR(); PHASE_IDS(); p10_phase(F); } SEAM(10);
    if (IN(11)) REP(11) { REPBAR(); PHASE_IDS(); sample_gemm<DFF>(F, ((bf16*)(F.ws + WS_ACT)), ((bf16*)(F.ws + WS_WDN)), ((float*)(F.ws + WS_X1)) + (size_t)MP * DM, ((float*)(F.ws + WS_MOD)) + 5120, F.out);
        pg8::Gemm g{((bf16*)(F.ws + WS_ACT)), ((bf16*)(F.ws + WS_WDN)), MP, DM, DFF}; pg8::StaticOrder S; S.init(MP, DM, F.G, (int)blockIdx.x);
        pg8::EpiResGate E{((float*)(F.ws + WS_X1)), ((float*)(F.ws + WS_X1)) + (size_t)MP * DM, ((float*)(F.ws + WS_MOD)) + 5120, F.out};
        pg8::gemm_phase<pg8::EpiResGate, pg8::StaticOrder, PG8_ALIGN, PG8_SP2>(F.lds + RING_OFF, g, S, E); }
#undef IN
#undef SEAM
}

#ifndef MK_N_LAUNCHES
#define MK_N_LAUNCHES 1
#endif
extern "C" void kernel_launch(void* const* d_in, const int* in_sizes, int n_in, void* d_out, int out_size, void* d_ws, size_t ws_size, hipStream_t stream) {
    static int grid = 0;
    if (grid == 0) {
        if (n_in != 34 || out_size != (int)O_END || ws_size < WS_END) { fprintf(stderr, "kernel_launch: unexpected shapes: n_in %d out %d ws %zu\n", n_in, out_size, ws_size); grid = -1; return; }
        int dev = 0, cus = 0, per_cu = 0;
        if (hipGetDevice(&dev) != hipSuccess || hipDeviceGetAttribute(&cus, hipDeviceAttributeMultiprocessorCount, dev) != hipSuccess) { grid = -1; return; }
        if (hipFuncSetAttribute((const void*)mk_fwd, hipFuncAttributeMaxDynamicSharedMemorySize, LDS_BYTES) != hipSuccess) { fprintf(stderr, "kernel_launch: hipFuncSetAttribute failed\n"); grid = -1; return; }
        if (hipOccupancyMaxActiveBlocksPerMultiprocessor(&per_cu, (const void*)mk_fwd, NWAVES * 64, LDS_BYTES) != hipSuccess || per_cu < 1) { fprintf(stderr, "kernel_launch: occupancy query says %d\n", per_cu); }
        (void)hipGetLastError();
        grid = cus;
    }
    if (grid < 0) return;
    if (hipMemsetAsync((char*)d_ws + WS_CTL, 0, CTL_ZERO_BYTES, stream) != hipSuccess) return;
    Args a{};
    for (int i = 0; i < 34; ++i) a.in[i] = d_in[i];
    a.out = (float*)d_out; a.ws = (unsigned char*)d_ws;
    if (MK_N_LAUNCHES == 1) { a.ph_lo = 0; a.ph_hi = N_PHASES; hipLaunchKernelGGL(mk_fwd, dim3(grid), dim3(NWAVES * 64), LDS_BYTES, stream, a); }
    else { for (int p = 0; p < N_PHASES; ++p) { a.ph_lo = p; a.ph_hi = p + 1; hipLaunchKernelGGL(mk_fwd, dim3(grid), dim3(NWAVES * 64), LDS_BYTES, stream, a); } }
}
```
